# Optimizing an MI355X kernel written in HIP

```python
import jax
import jax.numpy as jnp
from jax import lax
import numpy as np


D_MODEL = 1024
BATCH = 4
SEQ = 4096
DEPTH = 2

N_A_LAYERS = DEPTH // 2
N_B_LAYERS = DEPTH - N_A_LAYERS
HEAD_DIM = 64
MIX_WIDTH = D_MODEL
MEM_HEADS = 4
MEM_WIDTH = MEM_HEADS * HEAD_DIM
MAIN_WIDTH = MIX_WIDTH - MEM_WIDTH
CHUNK = 128
A_GROUPS = 6
A_GROUP_DIM = MAIN_WIDTH // A_GROUPS
FOX_HEADS = MAIN_WIDTH // HEAD_DIM
Q_BLOCK = 128
N_MEM = 256
D_FF = -(-8 * D_MODEL // (3 * 256)) * 256
RMS_EPS = 1e-6
LN_EPS = 1e-5
FORGET_BIAS = 4.0

kernel_name = "yoco_gmlp_fox_memory_hybrid"


def rmsnorm(x, g):
    xf = x.astype(jnp.float32)
    y = xf * lax.rsqrt(jnp.mean(xf * xf, axis=-1, keepdims=True) + RMS_EPS)
    return (y * g.astype(jnp.float32)).astype(x.dtype)


def layernorm(x, g, b):
    xf = x.astype(jnp.float32)
    mu = jnp.mean(xf, axis=-1, keepdims=True)
    xc = xf - mu
    y = xc * lax.rsqrt(jnp.mean(xc * xc, axis=-1, keepdims=True) + LN_EPS)
    return (y * g.astype(jnp.float32) + b.astype(jnp.float32)).astype(x.dtype)


def memory_attention(q_mem, mem_n, w_mem_kv):
    B, S, _ = q_mem.shape
    M = mem_n.shape[1]
    k, v = jnp.split(mem_n @ w_mem_kv, 2, axis=-1)
    q = q_mem.reshape(B, S, MEM_HEADS, HEAD_DIM)
    k = k.reshape(B, M, MEM_HEADS, HEAD_DIM)
    v = v.reshape(B, M, MEM_HEADS, HEAD_DIM)
    logits = jnp.einsum('bshd,bmhd->bhsm', q, k).astype(jnp.float32) * (HEAD_DIM ** -0.5)
    p = jax.nn.softmax(logits, axis=-1).astype(v.dtype)
    o = jnp.einsum('bhsm,bmhd->bshd', p, v)
    return o.reshape(B, S, MEM_WIDTH)


def chunked_spatial_gating(u, v, w_s, b_s, ln_g, ln_b):
    B, S, _ = u.shape
    u = jax.nn.gelu(u)
    v = layernorm(jax.nn.gelu(v), ln_g, ln_b)
    nc = S // CHUNK
    vc = v.reshape(B, nc, CHUNK, A_GROUPS, A_GROUP_DIM)
    mask = jnp.tril(jnp.ones((CHUNK, CHUNK), dtype=bool))
    w = jnp.where(mask[None], w_s, jnp.zeros((), w_s.dtype))
    s = jnp.einsum('gts,bcsgd->bctgd', w, vc) + b_s.T[None, None, :, :, None]
    return u * s.reshape(B, S, MAIN_WIDTH)


def forgetting_attention(q, k, v, log_f):
    B, S, H, Dh = q.shape
    c = jnp.cumsum(log_f, axis=1)
    cT = c.transpose(0, 2, 1)
    nb = S // Q_BLOCK
    qb = q.reshape(B, nb, Q_BLOCK, H, Dh).transpose(1, 0, 2, 3, 4)
    cb = cT.reshape(B, H, nb, Q_BLOCK).transpose(2, 0, 1, 3)
    kpos = jnp.arange(S)
    scale = Dh ** -0.5

    def block(args):
        i, qi, ci = args
        qpos = i * Q_BLOCK + jnp.arange(Q_BLOCK)
        logits = jnp.einsum('bthd,bshd->bhts', qi, k).astype(jnp.float32) * scale
        logits = logits + ci[..., :, None] - cT[..., None, :]
        mask = kpos[None, :] <= qpos[:, None]
        logits = jnp.where(mask, logits, -jnp.inf)
        p = jax.nn.softmax(logits, axis=-1).astype(v.dtype)
        return jnp.einsum('bhts,bshd->bthd', p, v)

    o = lax.map(block, (jnp.arange(nb), qb, cb))
    return o.transpose(1, 0, 2, 3, 4).reshape(B, S, H * Dh)


def setup_inputs(seed: int = 0) -> dict:
    key = jax.random.key(seed)
    ks = jax.random.split(key, 24)
    f32 = jnp.float32

    def dense(k, shape, fan_in):
        return jax.random.normal(k, shape, f32) * (fan_in ** -0.5)

    def gain(k, shape):
        return 1.0 + 0.05 * jax.random.normal(k, shape, f32)

    x = jax.random.normal(ks[0], (BATCH, SEQ, D_MODEL), f32)
    mem = jax.random.normal(ks[1], (BATCH, N_MEM, D_MODEL), f32)
    w_shared_kv = jnp.concatenate([
        dense(ks[19], (D_MODEL, 2 * MAIN_WIDTH), D_MODEL),
        0.1 * dense(ks[20], (D_MODEL, FOX_HEADS), D_MODEL)], axis=-1)
    return {
        'x': x,
        'mem': mem,
        'ln_mix_pre': gain(ks[2], (DEPTH, D_MODEL)),
        'ln_mix_post': gain(ks[3], (DEPTH, D_MODEL)),
        'ln_ffn_pre': gain(ks[4], (DEPTH, D_MODEL)),
        'ln_ffn_post': gain(ks[5], (DEPTH, D_MODEL)),
        'ln_mem': gain(ks[6], (DEPTH, D_MODEL)),
        'w_mem_kv': dense(ks[7], (DEPTH, D_MODEL, 2 * MEM_WIDTH), D_MODEL),
        'w_out': dense(ks[8], (DEPTH, MIX_WIDTH, D_MODEL), MIX_WIDTH),
        'w_ffn_gate': dense(ks[9], (DEPTH, D_MODEL, D_FF), D_MODEL),
        'w_ffn_up': dense(ks[10], (DEPTH, D_MODEL, D_FF), D_MODEL),
        'w_ffn_down': dense(ks[11], (DEPTH, D_FF, D_MODEL), D_FF),
        'w_in_a': dense(ks[12], (N_A_LAYERS, D_MODEL, 2 * MAIN_WIDTH + MEM_WIDTH), D_MODEL),
        'w_spatial': dense(ks[13], (N_A_LAYERS, A_GROUPS, CHUNK, CHUNK), CHUNK),
        'b_spatial': 1.0 + 0.05 * jax.random.normal(ks[14], (N_A_LAYERS, A_GROUPS, CHUNK), f32),
        'ln_v_g': gain(ks[15], (N_A_LAYERS, MAIN_WIDTH)),
        'ln_v_b': 0.02 * jax.random.normal(ks[16], (N_A_LAYERS, MAIN_WIDTH), f32),
        'ln_shared': gain(ks[17], (D_MODEL,)),
        'w_shared_kv': w_shared_kv,
        'b_forget': FORGET_BIAS + 0.1 * jax.random.normal(ks[18], (FOX_HEADS,), f32),
        'w_in_b': dense(ks[21], (N_B_LAYERS, D_MODEL, MAIN_WIDTH + MEM_WIDTH), D_MODEL),
    }


def reference(x, mem, ln_mix_pre, ln_mix_post, ln_ffn_pre, ln_ffn_post, ln_mem,
              w_mem_kv, w_out, w_ffn_gate, w_ffn_up, w_ffn_down, w_in_a,
              w_spatial, b_spatial, ln_v_g, ln_v_b, ln_shared, w_shared_kv,
              b_forget, w_in_b):
    B, S, _ = x.shape
    h = x
    k_s = v_s = log_f_s = None
    for layer in range(DEPTH):
        a = rmsnorm(h, ln_mix_pre[layer])
        mem_n = rmsnorm(mem, ln_mem[layer])
        if layer < N_A_LAYERS:
            proj = a @ w_in_a[layer]
            u = proj[..., :MAIN_WIDTH]
            v = proj[..., MAIN_WIDTH:2 * MAIN_WIDTH]
            q_mem = proj[..., 2 * MAIN_WIDTH:]
            main = chunked_spatial_gating(u, v, w_spatial[layer], b_spatial[layer],
                                          ln_v_g[layer], ln_v_b[layer])
        else:
            if layer == N_A_LAYERS:
                s_in = rmsnorm(h, ln_shared)
                kvf = s_in @ w_shared_kv
                k_s = kvf[..., :MAIN_WIDTH].reshape(B, S, FOX_HEADS, HEAD_DIM)
                v_s = kvf[..., MAIN_WIDTH:2 * MAIN_WIDTH].reshape(B, S, FOX_HEADS, HEAD_DIM)
                log_f_s = jax.nn.log_sigmoid(kvf[..., 2 * MAIN_WIDTH:].astype(jnp.float32)
                                             + b_forget.astype(jnp.float32))
            proj = a @ w_in_b[layer - N_A_LAYERS]
            q = proj[..., :MAIN_WIDTH].reshape(B, S, FOX_HEADS, HEAD_DIM)
            q_mem = proj[..., MAIN_WIDTH:]
            main = forgetting_attention(q, k_s, v_s, log_f_s)
        mixed = jnp.concatenate([main, memory_attention(q_mem, mem_n, w_mem_kv[layer])], axis=-1)
        h = h + rmsnorm(mixed @ w_out[layer], ln_mix_post[layer])
        f = rmsnorm(h, ln_ffn_pre[layer])
        f = (jax.nn.silu(f @ w_ffn_gate[layer]) * (f @ w_ffn_up[layer])) @ w_ffn_down[layer]
        h = h + rmsnorm(f, ln_ffn_post[layer])
    return h
```

```cpp
#include <hip/hip_runtime.h>
#include <hip/hip_bf16.h>
#include <cstdio>
#include <cstdint>
#include <cmath>

#ifndef MK_N_LAUNCHES
#define MK_N_LAUNCHES 1
#endif

constexpr int BATCH = 4, SEQ = 4096, D = 1024, M = BATCH * SEQ;
constexpr int MAINW = 768, MEMW = 256, NMEM = 256, FF = 2816, FOXH = 12, MEMH = 4, CHUNK = 128, NGRP = 6;
constexpr int N_INA = 2 * MAINW + MEMW;
constexpr int N_P1 = 2816;
constexpr int N_SKV = 2 * MAINW + FOXH;
constexpr float RMS_EPS = 1e-6f, LN_EPS = 1e-5f;
constexpr float LOG2E = 1.4426950408889634f;
constexpr float C2 = 0.125f * LOG2E;
constexpr int NPHASE = 12;

namespace pg8 {
#define PG8_LAS __attribute__((address_space(3)))
typedef unsigned short bf16_t;
typedef short bf16x8 __attribute__((ext_vector_type(8)));
typedef float f32x4 __attribute__((ext_vector_type(4)));
typedef float f32x2 __attribute__((ext_vector_type(2)));
typedef unsigned u32x4 __attribute__((ext_vector_type(4)));
typedef unsigned u32x2 __attribute__((ext_vector_type(2)));
constexpr int BM = 256, BK = 64, HALF = 128, HTB = HALF * BK * 2, STAGE_BYTES = 8 * HTB, NXCD = 8, WGM = 8;

__host__ __device__ __forceinline__ int lds_byte(int r, int c) { const int st = (r >> 4) * 2 + (c >> 5), rr = r & 15, cc = c & 31, ob = rr * 64 + cc * 2; return st * 1024 + (ob ^ (((ob >> 9) & 1) << 5)); }
__host__ __device__ __forceinline__ void stage_rc(int b, int& R, int& C) { const int st = b / 1024, sb = b % 1024, swz = sb ^ (((sb >> 9) & 1) << 5); R = (st >> 1) * 16 + swz / 64; C = (st & 1) * 32 + (swz % 64) / 2; }
__host__ __device__ __forceinline__ int perm32(int rho) { const int n = rho >> 4, i = rho & 15; return 8 * (i >> 2) + 4 * n + (i & 3); }

struct Unit { int pm, pn, kind, half; };

template <int MODE>
struct SchedT {
    const char* A0; const char* B0; const char* A1; const char* B1;
    int nM, nN, nwg, G, c, nextra, nfull, tailfirst; size_t tstep, hstepb;
    __device__ __forceinline__ void init(const void* A, const void* Bt, int M_, int N_, int K_, int G_, int c_) { A0 = (const char*)A; B0 = (const char*)Bt; A1 = B1 = nullptr; nM = M_ / BM; nN = N_ / BM; nwg = nM * nN; G = G_; c = c_; nextra = 0; nfull = nwg; tailfirst = 0; tstep = (size_t)BM * K_ * 2; hstepb = tstep / 2; }
    __device__ __forceinline__ void tail_tile_first() {}
    __device__ __forceinline__ void split_tail() { const int r = nwg % G; if (r != 0 && 2 * r <= G) nfull = nwg - r; }
    __device__ __forceinline__ void extra(const void* A, const void* B) { A1 = (const char*)A; B1 = (const char*)B; nextra = 16; }
    __device__ __forceinline__ bool next(int i, Unit& u) const {
        if constexpr (MODE == 1) {
            const int jm = c >> 6, gi = c & 63, pmc = 8 * (c & 7) + ((c >> 3) & 7);
            if (i >= ((jm < 3 || gi < 16) ? 2 : 1)) return false;
            const bool mk = (jm == 3) && (i == 1); const int e = gi;
            u.kind = mk ? 1 + (e >> 3) : 0; u.half = 0;
            u.pm = mk ? ((e & 7) >> 1) : pmc;
            u.pn = mk ? (e & 1) : (jm == 3 ? 6 : (i == 0 ? 3 + jm : jm));
            return true;
        }
        if constexpr (MODE == 2) {
            const int nlo = G - nM; const bool hiwg = c >= nlo;
            if (i >= (hiwg ? 2 : 3)) return false;
            const bool fg = hiwg && i == 0; const int r = hiwg ? 3 * nlo + (c - nlo) : i * nlo + c;
            const int nNr = nN - 1, nr = nM * nNr; int wgid = fg ? 0 : r; { const int q = nr / NXCD, rr = nr % NXCD, xcd = wgid % NXCD, off = wgid / NXCD; wgid = (xcd < rr ? xcd * (q + 1) : rr * (q + 1) + (xcd - rr) * q) + off; }
            const int nig = WGM * nNr, gid = wgid / nig, fm = gid * WGM, gsz = (nM - fm) < WGM ? (nM - fm) : WGM;
            u.pm = fg ? (8 * (c & 7) + ((c >> 3) & 7)) : fm + ((wgid % nig) % gsz);        u.pn = fg ? nNr : (wgid % nig) / gsz; u.kind = 0; u.half = 0; return true;
        }
        if constexpr (MODE == 3) {
            if (i > 5) return false;
            const bool tl = (i == 5); const int jm = c >> 6;
            int wgid = (tl ? 0 : i) * G + c; { const int q = nwg / NXCD, r = nwg % NXCD, xcd = wgid % NXCD, off = wgid / NXCD; wgid = (xcd < r ? xcd * (q + 1) : r * (q + 1) + (xcd - r) * q) + off; }
            const int nig = WGM * nN, gid = wgid / nig, fm = gid * WGM, gsz = (nM - fm) < WGM ? (nM - fm) : WGM;
            u.pm = tl ? (8 * (c & 7) + ((c >> 3) & 7)) : fm + ((wgid % nig) % gsz); u.pn = tl ? 20 + (jm >> 1) : (wgid % nig) / gsz; u.kind = 0; u.half = tl ? 1 + (jm & 1) : 0; return true;
        }
        const long L = (long)i * G + c; const int nhalf = 2 * (nwg - nfull); if (L >= nfull + nhalf + nextra) return false;
        const bool hf = L >= nfull && L < nfull + nhalf; const bool ex = L >= nfull + nhalf; const int j = (int)L - nfull - nhalf;
        int wgid = ex ? 0 : (hf ? nfull + (((int)L - nfull) >> 1) : (int)L); { const int q = nwg / NXCD, r = nwg % NXCD, xcd = wgid % NXCD, off = wgid / NXCD; wgid = (xcd < r ? xcd * (q + 1) : r * (q + 1) + (xcd - r) * q) + off; }
        const int nig = WGM * nN, gid = wgid / nig, fm = gid * WGM, gsz = (nM - fm) < WGM ? (nM - fm) : WGM;
        const int pm0 = fm + ((wgid % nig) % gsz), pn0 = (wgid % nig) / gsz;
        u.pm = ex ? ((j & 7) >> 1) : pm0; u.pn = ex ? (j & 1) : pn0; u.kind = ex ? 1 + (j >> 3) : 0; u.half = hf ? 1 + (((int)L - nfull) & 1) : 0; return true;
    }
    __device__ __forceinline__ void ptrs(const Unit& u, const char*& A, const char*& B) const {
        if (u.kind == 0) { A = A0 + (size_t)u.pm * tstep + (u.half == 2 ? hstepb : 0); B = B0 + (size_t)u.pn * tstep; }
        else { A = A1 + (size_t)u.pm * tstep; B = B1 + (size_t)((u.kind - 1) * 2 + u.pn) * tstep; }
    }
};
typedef SchedT<0> Sched;

__device__ __forceinline__ unsigned cvt_pk_bf16(float lo, float hi) { unsigned r; asm volatile("v_cvt_pk_bf16_f32 %0, %1, %2" : "=v"(r) : "v"(lo), "v"(hi)); return r; }
__device__ __forceinline__ float gelu_tanh(float x) {
    const float z = x * (1.0f + 0.044715f * x * x);
    const float e = __builtin_amdgcn_exp2f(z * (-2.0f * 0.7978845608028654f * LOG2E));
    return x * __builtin_amdgcn_rcpf(1.0f + e);
}
__device__ __forceinline__ f32x2 gelu_tanh2(f32x2 x) {
    const f32x2 w = (x * x) * (0.044715f * (-2.0f * 0.7978845608028654f * LOG2E)) + (-2.0f * 0.7978845608028654f * LOG2E);
    const f32x2 t = x * w; f32x2 e; e.x = __builtin_amdgcn_exp2f(t.x); e.y = __builtin_amdgcn_exp2f(t.y);
    const f32x2 d = e + 1.0f; f32x2 q; q.x = __builtin_amdgcn_rcpf(d.x); q.y = __builtin_amdgcn_rcpf(d.y);
    return x * q;
}
__device__ __forceinline__ float silu_f(float x) { return x * __builtin_amdgcn_rcpf(1.0f + __builtin_amdgcn_exp2f(-LOG2E * x)); }

template <int ACT>
__device__ __forceinline__ void store_tile_bf16(const f32x4 (&acc)[2][2][4][2], bf16_t* base, int ldc, int row0, int col0, float scale, float* st, int sidx, const PG8_LAS float* rtab = nullptr) {
#pragma unroll
    for (int ai = 0; ai < 2; ++ai)
#pragma unroll
        for (int m = 0; m < 4; ++m) {
            const int row = row0 + ai * HALF + m * 16; bf16_t* rowp = base + (size_t)row * ldc + col0; float s = 0.f, q = 0.f; float rs = scale;
            if (ACT == 3 || rtab != nullptr) rs = scale * rtab[(row0 & 255) + ai * HALF + m * 16];
#pragma unroll
            for (int bj = 0; bj < 2; ++bj) {
                f32x4 v0 = acc[ai][bj][m][0], v1 = acc[ai][bj][m][1];
                if (ACT == 0 || ACT == 3) { v0 = v0 * rs; v1 = v1 * rs; }
                else {
#pragma unroll
                    for (int j = 0; j < 4; j += 2) { const f32x2 a = gelu_tanh2((f32x2){v0[j], v0[j + 1]} * rs), b = gelu_tanh2((f32x2){v1[j], v1[j + 1]} * rs);
                        v0[j] = a.x; v0[j + 1] = a.y; v1[j] = b.x; v1[j + 1] = b.y;
                        if (ACT == 2) { const f32x2 sm = a + b, sq = a * a + b * b; s += sm.x + sm.y; q += sq.x + sq.y; } }
                }
                u32x4 w; w.x = cvt_pk_bf16(v0[0], v0[1]); w.y = cvt_pk_bf16(v0[2], v0[3]); w.z = cvt_pk_bf16(v1[0], v1[1]); w.w = cvt_pk_bf16(v1[2], v1[3]);
                *(u32x4*)(rowp + bj * HALF) = w;
            }
            if (ACT == 2) { s += __shfl_xor(s, 16); s += __shfl_xor(s, 32); q += __shfl_xor(q, 16); q += __shfl_xor(q, 32);
                if ((threadIdx.x & 63) < 16) *(f32x2*)(st + ((size_t)row * 12 + sidx) * 2) = (f32x2){s, q}; }
        }
}
struct EpiP1 {
    static constexpr bool PERM = true, AFTER_DRAIN = false;
    static __device__ __forceinline__ bool relax_after(const Unit&) { return true; }
    bf16_t *U, *GV, *QM, *KVM; float* vst; const PG8_LAS float* rtab;
    __device__ __forceinline__ void operator()(const f32x4 (&acc)[2][2][4][2], const Unit& u, int ui, int wr, int wc, int fr, int fq) const {
        const int row0 = u.pm * BM + wr * 64 + fr, cw = wc * 32 + 8 * fq; const PG8_LAS float* rt = rtab + ui * 256;
        if (u.kind != 0) store_tile_bf16<0>(acc, KVM + (size_t)(u.kind - 1) * (BATCH * NMEM * 2 * MEMW), 2 * MEMW, row0, u.pn * BM + cw, 1.f, nullptr, 0);
        else if (u.pn < 3) store_tile_bf16<1>(acc, U, MAINW, row0, u.pn * BM + cw, 1.f, nullptr, 0, rt);
        else if (u.pn < 6) store_tile_bf16<2>(acc, GV, MAINW, row0, (u.pn - 3) * BM + cw, 1.f, vst, (u.pn - 3) * 4 + wc, rt);
        else store_tile_bf16<3>(acc, QM, MEMW, row0, cw, C2, nullptr, 0, rt);
    }
};
struct EpiP6 {
    static constexpr bool PERM = true, AFTER_DRAIN = false;
    static __device__ __forceinline__ bool relax_after(const Unit& u) { return u.pn < 10; }
    bf16_t *Q, *QM, *K, *V; float* CL; float* TT; const float* bfg; const PG8_LAS float* rtab; PG8_LAS float* segl; const unsigned* guard; unsigned nguard;
    __device__ __forceinline__ void operator()(const f32x4 (&acc)[2][2][4][2], const Unit& u, int ui, int wr, int wc, int fr, int fq) const {
        const int row0 = u.pm * BM + wr * 64 + fr, cw = wc * 32 + 8 * fq; const PG8_LAS float* rt = rtab + ui * 256;
        if (ui == 0) { unsigned sp = 0u; while (__hip_atomic_load(guard, __ATOMIC_RELAXED, __HIP_MEMORY_SCOPE_AGENT) < nguard) { __builtin_amdgcn_s_sleep(2); if (++sp > (1u << 20)) break; } }
        if (u.pn < 3) store_tile_bf16<3>(acc, Q, MAINW, row0, u.pn * BM + cw, C2, nullptr, 0, rt);
        else if (u.pn == 3) store_tile_bf16<3>(acc, QM, MEMW, row0, cw, C2, nullptr, 0, rt);
        else if (u.pn < 7) store_tile_bf16<3>(acc, K, MAINW, row0, (u.pn - 4) * BM + cw, 1.f, nullptr, 0, rt);
        else if (u.pn < 10) store_tile_bf16<3>(acc, V, MAINW, row0, (u.pn - 7) * BM + cw, 1.f, nullptr, 0, rt);
        else {
            const bool holder = (wc == 0) && (fq < 2);
#define FG_LF(v_) do { _Pragma("unroll") for (int j_ = 0; j_ < 4; ++j_) { const float x_ = v_[j_]; \
                v_[j_] = fminf(x_, 0.f) - 0.6931471805599453f * __builtin_amdgcn_logf(1.0f + __builtin_amdgcn_exp2f(-fabsf(x_) * LOG2E)); } } while (0)
#define FG_SCAN(v_) do { _Pragma("unroll") for (int o_ = 1; o_ < 16; o_ <<= 1) _Pragma("unroll") for (int j_ = 0; j_ < 4; ++j_) { const float t_ = __shfl_up(v_[j_], o_, 16); if (fr >= o_) v_[j_] += t_; } } while (0)
            f32x4 b0 = (f32x4){0.f, 0.f, 0.f, 0.f}, b1 = b0;
            if (holder) { b0 = *(const f32x4*)(bfg + 8 * fq); b1 = *(const f32x4*)(bfg + 4);
#pragma unroll
                for (int ai = 0; ai < 2; ++ai) { f32x4 s0 = (f32x4){0.f, 0.f, 0.f, 0.f}, s1 = s0;
#pragma unroll
                    for (int m = 0; m < 4; ++m) { const float r = rt[ai * HALF + wr * 64 + m * 16 + fr]; f32x4 v0 = acc[ai][0][m][0] * r + b0, v1 = acc[ai][0][m][1] * r + b1; FG_LF(v0); FG_LF(v1); s0 = s0 + v0; s1 = s1 + v1; }
#pragma unroll
                    for (int o = 1; o < 16; o <<= 1)
#pragma unroll
                        for (int j = 0; j < 4; ++j) { s0[j] += __shfl_xor(s0[j], o, 16); s1[j] += __shfl_xor(s1[j], o, 16); }
                    if (fr == 0) { PG8_LAS float* sp = segl + (ai * 2 + wr) * 12 + 8 * fq; *(PG8_LAS f32x4*)sp = s0; if (fq == 0) *(PG8_LAS f32x4*)(sp + 4) = s1; } }
            }
            asm volatile("s_waitcnt lgkmcnt(0)" ::: "memory"); __builtin_amdgcn_s_barrier(); asm volatile("" ::: "memory");
            if (holder) {
                const int b = u.pm >> 4, t0 = (u.pm & 15) * BM;
#pragma unroll
                for (int ai = 0; ai < 2; ++ai) { const int seg = ai * 2 + wr; f32x4 car0 = (f32x4){0.f, 0.f, 0.f, 0.f}, car1 = car0;
#pragma unroll
                    for (int sg = 0; sg < 3; ++sg) if (sg < seg) { car0 = car0 + *(const PG8_LAS f32x4*)(segl + sg * 12 + 8 * fq); car1 = car1 + *(const PG8_LAS f32x4*)(segl + sg * 12 + 4); }
#pragma unroll
                    for (int m = 0; m < 4; ++m) { const float r = rt[ai * HALF + wr * 64 + m * 16 + fr]; f32x4 v0 = acc[ai][0][m][0] * r + b0, v1 = acc[ai][0][m][1] * r + b1; FG_LF(v0); FG_LF(v1); FG_SCAN(v0); FG_SCAN(v1);
                        v0 = v0 + car0; v1 = v1 + car1;
                        const int row = t0 + ai * HALF + wr * 64 + m * 16 + fr;
#pragma unroll
                        for (int j = 0; j < 4; ++j) { CL[(size_t)(b * FOXH + 8 * fq + j) * SEQ + row] = v0[j]; if (fq == 0) CL[(size_t)(b * FOXH + 4 + j) * SEQ + row] = v1[j]; }
#pragma unroll
                        for (int j = 0; j < 4; ++j) { car0[j] = __shfl(v0[j], 15, 16); car1[j] = __shfl(v1[j], 15, 16); } }
                    if (ai == 1 && wr == 1 && fr == 15) {
#pragma unroll
                        for (int j = 0; j < 4; ++j) { TT[u.pm * FOXH + 8 * fq + j] = car0[j]; if (fq == 0) TT[u.pm * FOXH + 4 + j] = car1[j]; } } }
            }
#undef FG_LF
#undef FG_SCAN
            asm volatile("s_waitcnt lgkmcnt(0)" ::: "memory"); __builtin_amdgcn_s_barrier(); asm volatile("" ::: "memory");
        }
    }
};
struct EpiGateUp {
    static constexpr bool PERM = true, AFTER_DRAIN = false;
    static __device__ __forceinline__ bool relax_after(const Unit& u) { return u.half == 0; }
    bf16_t* H; const PG8_LAS float* rtab;
    __device__ __forceinline__ void operator()(const f32x4 (&acc)[2][2][4][2], const Unit& u, int ui, int wr, int wc, int fr, int fq) const {
        const int hb = (u.half == 2) ? HALF : 0, rl0 = hb + wr * 64 + fr, col0 = u.pn * HALF + wc * 32 + 8 * fq; const PG8_LAS float* rt = rtab + ui * 256 + rl0;
#pragma unroll
        for (int ai = 0; ai < 2; ++ai) {
            if (ai == 1 && u.half != 0) break;
#pragma unroll
            for (int m = 0; m < 4; ++m) {
                const float r = rt[ai * HALF + m * 16]; const float nr = -LOG2E * r, ri2 = __builtin_amdgcn_rcpf(r * r);
                f32x4 v0, v1;
#pragma unroll
                for (int n = 0; n < 2; ++n)
#pragma unroll
                    for (int j = 0; j < 4; j += 2) {
                        const f32x2 g = (f32x2){acc[ai][0][m][n][j], acc[ai][0][m][n][j + 1]}, uu = (f32x2){acc[ai][1][m][n][j], acc[ai][1][m][n][j + 1]};
                        const f32x2 t = g * nr; f32x2 e; e.x = __builtin_amdgcn_exp2f(t.x); e.y = __builtin_amdgcn_exp2f(t.y);
                        const f32x2 d = e * ri2 + ri2; f32x2 q; q.x = __builtin_amdgcn_rcpf(d.x); q.y = __builtin_amdgcn_rcpf(d.y);
                        const f32x2 o = (g * uu) * q;
                        if (n == 0) { v0[j] = o.x; v0[j + 1] = o.y; } else { v1[j] = o.x; v1[j + 1] = o.y; }
                    }
                u32x4 w; w.x = cvt_pk_bf16(v0[0], v0[1]); w.y = cvt_pk_bf16(v0[2], v0[3]); w.z = cvt_pk_bf16(v1[0], v1[1]); w.w = cvt_pk_bf16(v1[2], v1[3]);
                *(u32x4*)(H + (size_t)(u.pm * BM + rl0 + ai * HALF + m * 16) * FF + col0) = w;
            }
        }
    }
};

constexpr unsigned XS_EMPTY = 0xFFFFFFFFu;
struct RowSumsq {
    unsigned* xbuf;
    unsigned* cnt;
    unsigned* tmo;
    float eps; unsigned code;
    __device__ __forceinline__ void publish(const f32x4 (&v)[2][2][4][2], const Unit& u, int wr, int wc, int fr, int fq, PG8_LAS unsigned char* lds, int wid, int lane) const {
        PG8_LAS float* P = (PG8_LAS float*)lds;
        PG8_LAS float* S = (PG8_LAS float*)(lds + 4096);
        PG8_LAS unsigned* flag = (PG8_LAS unsigned*)(lds + 4096 + 1024);
#pragma unroll
        for (int ai = 0; ai < 2; ++ai)
#pragma unroll
            for (int m = 0; m < 4; ++m) {
                float q = 0.f;
#pragma unroll
                for (int bj = 0; bj < 2; ++bj)
#pragma unroll
                    for (int n = 0; n < 2; ++n) { const f32x4 x = v[ai][bj][m][n]; q += (x[0] * x[0] + x[1] * x[1]) + (x[2] * x[2] + x[3] * x[3]); }
                q += __shfl_xor(q, 16); q += __shfl_xor(q, 32);
                if (fq == 0) P[(ai * HALF + wr * 64 + m * 16 + fr) * 4 + wc] = q;
            }
        if (wid == 0 && lane == 0) flag[0] = 0u;
        asm volatile("s_waitcnt lgkmcnt(0)" ::: "memory"); __builtin_amdgcn_s_barrier(); asm volatile("" ::: "memory");
        const int row = wid * 32 + (lane & 31);
        if (lane < 32) {
            const float tot = (P[row * 4 + 0] + P[row * 4 + 1]) + (P[row * 4 + 2] + P[row * 4 + 3]);
            __hip_atomic_store(xbuf + ((size_t)(u.pm * BM + row) * 4 + u.pn), __float_as_uint(tot), __ATOMIC_RELAXED, __HIP_MEMORY_SCOPE_AGENT);
        }
    }
    __device__ __forceinline__ bool finish(const Unit& u, PG8_LAS unsigned char* lds, int wid, int lane) const {
        PG8_LAS float* S = (PG8_LAS float*)(lds + 4096);
        PG8_LAS unsigned* flag = (PG8_LAS unsigned*)(lds + 4096 + 1024);
        const int row = wid * 32 + (lane & 31);
        if (lane < 32) {
            const unsigned* slot = xbuf + (size_t)(u.pm * BM + row) * 4; unsigned v0, v1, v2, v3, sp = 0u; bool dead = false;
            for (;;) {
                v0 = __hip_atomic_load(slot + 0, __ATOMIC_RELAXED, __HIP_MEMORY_SCOPE_AGENT); v1 = __hip_atomic_load(slot + 1, __ATOMIC_RELAXED, __HIP_MEMORY_SCOPE_AGENT);
                v2 = __hip_atomic_load(slot + 2, __ATOMIC_RELAXED, __HIP_MEMORY_SCOPE_AGENT); v3 = __hip_atomic_load(slot + 3, __ATOMIC_RELAXED, __HIP_MEMORY_SCOPE_AGENT);
                if (v0 != XS_EMPTY && v1 != XS_EMPTY && v2 != XS_EMPTY && v3 != XS_EMPTY) break;
                __builtin_amdgcn_s_sleep(1);
                if ((++sp & 63u) == 0u) { if (__hip_atomic_load(tmo, __ATOMIC_RELAXED, __HIP_MEMORY_SCOPE_AGENT) != 0u) { dead = true; break; }
                    if (sp > (1u << 17)) { unsigned expect = 0u; __hip_atomic_compare_exchange_strong(tmo + 1, &expect, code | (unsigned)(u.pm & 0xff), __ATOMIC_RELAXED, __ATOMIC_RELAXED, __HIP_MEMORY_SCOPE_AGENT);
                                           __hip_atomic_store(tmo, 1u, __ATOMIC_RELAXED, __HIP_MEMORY_SCOPE_AGENT); dead = true; break; } }
            }
            const float tot = (__uint_as_float(v0) + __uint_as_float(v1)) + (__uint_as_float(v2) + __uint_as_float(v3));
            S[row] = 1.0f / sqrtf(tot * (1.0f / 1024.0f) + eps);
            if (dead) flag[0] = 1u;
        }
        asm volatile("s_waitcnt lgkmcnt(0)" ::: "memory"); __builtin_amdgcn_s_barrier(); asm volatile("" ::: "memory");
        return flag[0] != 0u;
    }
};
template <bool BASE_F32, bool OUT_F32>
struct EpiRmsRes {
    static constexpr bool PERM = true, AFTER_DRAIN = true;
    static __device__ __forceinline__ bool relax_after(const Unit&) { return false; }
    const float* basef; const bf16_t* baseh; float* outf; bf16_t* outh; float* ssq; const float* g1; RowSumsq st1; unsigned poison; int skip;
    __device__ __forceinline__ void fused(f32x4 (&acc)[2][2][4][2], const Unit& u, int wr, int wc, int fr, int fq, PG8_LAS unsigned char* lds, int wid, int lane) const {
        if (skip) return;
        const PG8_LAS float* S = (const PG8_LAS float*)(lds + 4096);
        PG8_LAS float* P = (PG8_LAS float*)lds;
        const int col0 = u.pn * BM + wc * 32 + 8 * fq;
        const size_t off0 = (size_t)(u.pm * BM + wr * 64 + fr) * D + col0;
        st1.publish(acc, u, wr, wc, fr, fq, lds, wid, lane);
        u32x4 pb[2][4][2]; f32x4 pf[4][2][2];
        if constexpr (BASE_F32) {
#pragma unroll
            for (int m = 0; m < 4; ++m)
#pragma unroll
                for (int bj = 0; bj < 2; ++bj)
#pragma unroll
                    for (int n = 0; n < 2; ++n) pf[m][bj][n] = *(const f32x4*)(basef + off0 + (size_t)(m * 16) * D + bj * HALF + 4 * n);
        } else {
#pragma unroll
            for (int ai = 0; ai < 2; ++ai)
#pragma unroll
                for (int m = 0; m < 4; ++m)
#pragma unroll
                    for (int bj = 0; bj < 2; ++bj) pb[ai][m][bj] = *(const u32x4*)(baseh + off0 + (size_t)(ai * HALF + m * 16) * D + bj * HALF);
        }
        f32x4 gv[2][2];
#pragma unroll
        for (int bj = 0; bj < 2; ++bj)
#pragma unroll
            for (int n = 0; n < 2; ++n) gv[bj][n] = *(const f32x4*)(g1 + col0 + bj * HALF + 4 * n);
        const bool bad = st1.finish(u, lds, wid, lane) || poison != 0u;
        const float qnan = __builtin_nanf("");
#pragma unroll
        for (int ai = 0; ai < 2; ++ai) {
            if constexpr (BASE_F32) { if (ai == 1) {
#pragma unroll
                for (int m = 0; m < 4; ++m)
#pragma unroll
                    for (int bj = 0; bj < 2; ++bj)
#pragma unroll
                        for (int n = 0; n < 2; ++n) pf[m][bj][n] = *(const f32x4*)(basef + off0 + (size_t)(HALF + m * 16) * D + bj * HALF + 4 * n); } }
#pragma unroll
            for (int m = 0; m < 4; ++m) { const int r = ai * HALF + wr * 64 + m * 16 + fr; const float sr = S[r]; const size_t off = off0 + (size_t)(ai * HALF + m * 16) * D; float q = 0.f;
#pragma unroll
                for (int bj = 0; bj < 2; ++bj) {
                    f32x4 h[2];
#pragma unroll
                    for (int n = 0; n < 2; ++n) {
                        f32x4 bs;
                        if constexpr (BASE_F32) bs = pf[m][bj][n];
                        else { const unsigned wlo = n == 0 ? pb[ai][m][bj].x : pb[ai][m][bj].z, whi = n == 0 ? pb[ai][m][bj].y : pb[ai][m][bj].w;
                               bs = (f32x4){__uint_as_float(wlo << 16), __uint_as_float(wlo & 0xffff0000u), __uint_as_float(whi << 16), __uint_as_float(whi & 0xffff0000u)}; }
                        h[n] = bs + (acc[ai][bj][m][n] * sr) * gv[bj][n];
                        if (bad) h[n] = (f32x4){qnan, qnan, qnan, qnan};
                    }
                    if constexpr (OUT_F32) { *(f32x4*)(outf + off + bj * HALF) = h[0]; *(f32x4*)(outf + off + bj * HALF + 4) = h[1]; }
                    else { u32x4 w; w.x = cvt_pk_bf16(h[0][0], h[0][1]); w.y = cvt_pk_bf16(h[0][2], h[0][3]); w.z = cvt_pk_bf16(h[1][0], h[1][1]); w.w = cvt_pk_bf16(h[1][2], h[1][3]); *(u32x4*)(outh + off + bj * HALF) = w;
#pragma unroll
                        for (int n = 0; n < 2; ++n) q += (h[n][0] * h[n][0] + h[n][1] * h[n][1]) + (h[n][2] * h[n][2] + h[n][3] * h[n][3]); }
                }
                if constexpr (!OUT_F32) { q += __shfl_xor(q, 16); q += __shfl_xor(q, 32); if (fq == 0) P[r * 4 + wc] = q; }
            }
        }
        if constexpr (!OUT_F32) {
            asm volatile("s_waitcnt lgkmcnt(0)" ::: "memory"); __builtin_amdgcn_s_barrier(); asm volatile("" ::: "memory");
            if (lane < 32) { const int row = wid * 32 + lane; ssq[(size_t)(u.pm * BM + row) * 4 + u.pn] = (P[row * 4 + 0] + P[row * 4 + 1]) + (P[row * 4 + 2] + P[row * 4 + 3]); }
        }
    }
};

template <class Epi, class SchedT, bool ALIGN_EPI, int RELAX = 0>
__device__ __forceinline__ void gemm_phase(PG8_LAS unsigned char* lds, const int K, const SchedT& S, const Epi& E, const int probe = 0) {
    int tid_o = threadIdx.x; asm volatile("" : "+v"(tid_o));
    const int tid = tid_o, wid = __builtin_amdgcn_readfirstlane(tid >> 6), lane = tid & 63, wr = wid >> 2, wc = wid & 3, fr = lane & 15, fq = lane >> 4;
    const int nt = K / BK;
    unsigned voffA[2], voffB[2];
#pragma unroll
    for (int i = 0; i < 2; ++i) { int R, C; stage_rc(tid * 16 + i * 8192, R, C); const int Rb = Epi::PERM ? ((R & ~31) + perm32(R & 31)) : R;
        voffA[i] = (unsigned)(R * K + C) * 2u; voffB[i] = (unsigned)(Rb * K + C) * 2u; }
    const size_t kstep = (size_t)(BK * 2);
    const size_t hstep = (size_t)HALF * K * 2;
    const unsigned ldsw = (unsigned)wid * 1024u;
    const int aoff = lds_byte(wr * 64 + fr, fq * 8), boff = lds_byte(wc * 32 + fr, fq * 8);
#define PG8_SA(b, h) (((b) * 2 + (h)) * HTB)
#define PG8_SB(b, h) ((4 + (b) * 2 + (h)) * HTB)
#define PG8_STAGE(bufoff, gbase, voff) do { if (probe == 2) break; _Pragma("unroll") for (int _i = 0; _i < 2; ++_i) \
        __builtin_amdgcn_global_load_lds((const unsigned*)((const char*)(gbase) + (voff)[_i]), (PG8_LAS unsigned*)(lds + (bufoff) + ldsw + _i * 8192), 16, 0, 0); } while (0)
#define PG8_LDA(dst, b, h) do { _Pragma("unroll") for (int m = 0; m < 4; ++m) _Pragma("unroll") for (int k = 0; k < 2; ++k) dst[m][k] = *(const PG8_LAS bf16x8*)(lds + PG8_SA(b, h) + aoff + m * 2048 + k * 1024); } while (0)
#define PG8_LDB(dst, b, h) do { _Pragma("unroll") for (int n = 0; n < 2; ++n) _Pragma("unroll") for (int k = 0; k < 2; ++k) dst[n][k] = *(const PG8_LAS bf16x8*)(lds + PG8_SB(b, h) + boff + n * 2048 + k * 1024); } while (0)
#define PG8_MMA(ai, bj, At, Bt) do { if (probe == 1) break; __builtin_amdgcn_s_setprio(1); _Pragma("unroll") for (int m = 0; m < 4; ++m) _Pragma("unroll") for (int n = 0; n < 2; ++n) _Pragma("unroll") for (int k = 0; k < 2; ++k) \
        acc[ai][bj][m][n] = __builtin_amdgcn_mfma_f32_16x16x32_bf16(Bt[n][k], At[m][k], acc[ai][bj][m][n], 0, 0, 0); __builtin_amdgcn_s_setprio(0); } while (0)
#define PG8_WAIT_V(n) asm volatile("s_waitcnt vmcnt(" #n ")" ::: "memory")
#define PG8_WAIT_L(n) asm volatile("s_waitcnt lgkmcnt(" #n ")" ::: "memory")
#define PG8_BAR __builtin_amdgcn_s_barrier()
#define PG8_SCHED __builtin_amdgcn_sched_barrier(0)
    Unit cur, nxt; int ui = 0;
    if (!S.next(0, cur)) return;
    f32x4 acc[2][2][4][2];
#pragma unroll
    for (int a = 0; a < 2; ++a)
#pragma unroll
        for (int b = 0; b < 2; ++b)
#pragma unroll
            for (int m = 0; m < 4; ++m)
#pragma unroll
                for (int n = 0; n < 2; ++n) acc[a][b][m][n] = (f32x4){0.f, 0.f, 0.f, 0.f};
    bf16x8 At[4][2], B0[2][2], B1[2][2];
    const char* cA; const char* cB; S.ptrs(cur, cA, cB);
    PG8_STAGE(PG8_SB(0, 0), cB, voffB); PG8_STAGE(PG8_SB(0, 1), cB + hstep, voffB); PG8_STAGE(PG8_SA(0, 0), cA, voffA); PG8_STAGE(PG8_SA(0, 1), cA + hstep, voffA);
    if (wr == 1) PG8_BAR;
    PG8_WAIT_V(2); PG8_BAR;
    PG8_STAGE(PG8_SB(1, 0), cB + kstep, voffB); PG8_STAGE(PG8_SA(1, 0), cA + kstep, voffA); PG8_STAGE(PG8_SB(1, 1), cB + hstep + kstep, voffB);
    PG8_WAIT_V(6); PG8_BAR;
    bool prev_ok = false; int t_first = 0; asm volatile("" : "+s"(t_first));
    for (;;) {
        const bool has_next = S.next(ui + 1, nxt);
        const char* nA = cA; const char* nB = cB; if (has_next) S.ptrs(nxt, nA, nB);
        const bool halfu = cur.half != 0;
        for (int t = 0; t < nt; t += 2) {
            const bool last = (t == nt - 2);
            const char* a1 = cA + (size_t)(t + 1) * kstep;
            const char* a2 = last ? nA : cA + (size_t)(t + 2) * kstep; const char* b2 = last ? nB : cB + (size_t)(t + 2) * kstep;
            const char* a3 = a2 + kstep; const char* b3 = b2 + kstep;
            const bool rlx = (RELAX != 0) && (t == t_first) && (ui > 0) && (probe == 0) && prev_ok;
            PG8_LDB(B0, 0, 0); PG8_LDB(B1, 0, 1); PG8_SCHED; PG8_LDA(At, 0, 0); PG8_STAGE(PG8_SA(1, 1), a1 + hstep, voffA);
            if (rlx) { if constexpr (RELAX == 8) PG8_WAIT_V(16); else if constexpr (RELAX == 16) PG8_WAIT_V(24); else PG8_WAIT_V(8); } else PG8_WAIT_V(8);
            PG8_WAIT_L(0); PG8_BAR; PG8_MMA(0, 0, At, B0); PG8_MMA(0, 1, At, B1); PG8_BAR; PG8_SCHED;
            if (!halfu) PG8_LDA(At, 0, 1); PG8_STAGE(PG8_SB(0, 0), b2, voffB); PG8_STAGE(PG8_SB(0, 1), b2 + hstep, voffB); PG8_STAGE(PG8_SA(0, 0), a2, voffA);
            if (rlx) { if constexpr (RELAX == 8) PG8_WAIT_V(16); else if constexpr (RELAX == 16) PG8_WAIT_V(24); else PG8_WAIT_V(8); } else PG8_WAIT_V(8);
            PG8_WAIT_L(0); PG8_BAR; if (!halfu) { PG8_MMA(1, 0, At, B0); PG8_MMA(1, 1, At, B1); } PG8_BAR; PG8_SCHED;
            PG8_LDB(B0, 1, 0); PG8_LDB(B1, 1, 1); PG8_SCHED; PG8_LDA(At, 1, 0); PG8_STAGE(PG8_SA(0, 1), a2 + hstep, voffA);
            PG8_WAIT_V(8); PG8_WAIT_L(0); PG8_BAR; PG8_MMA(0, 0, At, B0); PG8_MMA(0, 1, At, B1); PG8_BAR; PG8_SCHED;
            if (!halfu) PG8_LDA(At, 1, 1); PG8_STAGE(PG8_SB(1, 0), b3, voffB); PG8_STAGE(PG8_SB(1, 1), b3 + hstep, voffB); PG8_STAGE(PG8_SA(1, 0), a3, voffA);
            PG8_WAIT_V(8); PG8_WAIT_L(0); PG8_BAR; if (!halfu) { PG8_MMA(1, 0, At, B0); PG8_MMA(1, 1, At, B1); } PG8_BAR; PG8_SCHED;
        }
        if constexpr (ALIGN_EPI) { if (wr == 0) PG8_BAR; }
        if constexpr (!Epi::AFTER_DRAIN) { if (probe == 0) E(acc, cur, ui, wr, wc, fr, fq); }
        if (!has_next) break;
#pragma unroll
        for (int a = 0; a < 2; ++a)
#pragma unroll
            for (int b = 0; b < 2; ++b)
#pragma unroll
                for (int m = 0; m < 4; ++m)
#pragma unroll
                    for (int n = 0; n < 2; ++n) acc[a][b][m][n] = (f32x4){0.f, 0.f, 0.f, 0.f};
        prev_ok = Epi::relax_after(cur); cur = nxt; cA = nA; cB = nB; ++ui;
        if constexpr (ALIGN_EPI) { if (wr == 1) PG8_BAR; }
    }
    PG8_WAIT_V(0);
    if constexpr (!ALIGN_EPI) { if (wr == 0) PG8_BAR; }
    PG8_BAR;
    if constexpr (Epi::AFTER_DRAIN) { E.fused(acc, cur, wr, wc, fr, fq, lds, wid, lane); }
#undef PG8_SA
#undef PG8_SB
#undef PG8_STAGE
#undef PG8_LDA
#undef PG8_LDB
#undef PG8_MMA
#undef PG8_WAIT_V
#undef PG8_WAIT_L
#undef PG8_BAR
#undef PG8_SCHED
}
}

namespace attn_body {
using bf16 = __hip_bfloat16;
using bf16x8 = __attribute__((ext_vector_type(8))) short;
using s16x4 = __attribute__((ext_vector_type(4))) short;
using f32x16 = __attribute__((ext_vector_type(16))) float;
using f32x4 = __attribute__((ext_vector_type(4))) float;
using u32x4 = __attribute__((ext_vector_type(4))) unsigned;
constexpr int NW = 8, QBLK = 32, QB = QBLK * NW, KVBLK = 64;
__device__ __forceinline__ int crow(int r, int hi) { return (r & 3) + 8 * (r >> 2) + 4 * hi; }
#define SBAR() __builtin_amdgcn_sched_barrier(0)
__device__ __forceinline__ void cmask(f32x16& p0, f32x16& p1, int jb, int qrel, int hi) {
    const float NEG = -INFINITY; int kb = 64 * jb + 4 * hi;
#pragma unroll
    for (int r = 0; r < 16; ++r) { int kv = kb + (r & 3) + 8 * (r >> 2); if (kv > qrel) p0[r] = NEG; if (kv + 32 > qrel) p1[r] = NEG; }
}
constexpr int NSLOT = 3, SLOTB = 8192;
constexpr int LDS_K = 0, LDS_V = NSLOT * SLOTB, LDS_WS = 2 * NSLOT * SLOTB, LDS_OST = LDS_WS + NW * 64 * 4, LDS_BIAS = LDS_OST + NW * 4096, LDS_BYTES = LDS_BIAS + 4096 * 8;
__device__ __forceinline__ void glds16(const void* gsrc, unsigned lds_dst) { unsigned keep;
    asm volatile("s_mov_b32 %0, m0\n\ts_mov_b32 m0, %2\n\ts_nop 0\n\tglobal_load_lds_dwordx4 %1, off\n\ts_mov_b32 m0, %0" : "=&s"(keep) : "v"(gsrc), "s"(lds_dst) : "memory"); }
__device__ __forceinline__ float max3f(float a, float b, float c) { float r; asm("v_max3_f32 %0, %1, %2, %3" : "=v"(r) : "v"(a), "v"(b), "v"(c)); return r; }
__device__ __forceinline__ float max2f(float a, float b) { float r; asm("v_max_f32_e32 %0, %1, %2" : "=v"(r) : "v"(a), "v"(b)); return r; }
__device__ __forceinline__ float fadd_s(float a, float b) { float r; asm("v_add_f32_e32 %0, %1, %2" : "=v"(r) : "v"(a), "v"(b)); return r; }
__device__ __forceinline__ float fsub_s(float a, float b) { float r; asm("v_sub_f32_e32 %0, %1, %2" : "=v"(r) : "v"(a), "v"(b)); return r; }
typedef float f32x2_t __attribute__((ext_vector_type(2))); typedef __bf16 bf16x2_t __attribute__((ext_vector_type(2)));
__device__ __forceinline__ unsigned cvtpk_s(float lo, float hi) { f32x2_t v = {lo, hi}; bf16x2_t b = __builtin_convertvector(v, bf16x2_t); return __builtin_bit_cast(unsigned, b); }
#define WAIT_BAR(N) asm volatile("s_waitcnt vmcnt(" #N ") lgkmcnt(0)\n\ts_barrier" ::: "memory")

__device__ __forceinline__ void qkt(f32x16& p0, f32x16& p1, const char* Kslot, const bf16x8* qr, const f32x16& negm, int r32, int hi) {
    const char* kb = Kslot + hi * 1024 + r32 * 16;
#pragma unroll
    for (int d0 = 0; d0 < 4; ++d0) {
        const bf16x8 b0 = *reinterpret_cast<const bf16x8*>(kb + d0 * 2048);
        const bf16x8 b1 = *reinterpret_cast<const bf16x8*>(kb + d0 * 2048 + 512);
        if (d0 == 0) { p0 = __builtin_amdgcn_mfma_f32_32x32x16_bf16(b0, qr[0], negm, 0, 0, 0); p1 = __builtin_amdgcn_mfma_f32_32x32x16_bf16(b1, qr[0], negm, 0, 0, 0); }
        else { p0 = __builtin_amdgcn_mfma_f32_32x32x16_bf16(b0, qr[d0], p0, 0, 0, 0); p1 = __builtin_amdgcn_mfma_f32_32x32x16_bf16(b1, qr[d0], p1, 0, 0, 0); } }
}
typedef __attribute__((address_space(3))) const char* lds_cptr;
typedef short v4i16_t __attribute__((ext_vector_type(4)));
__device__ __forceinline__ void kload8(bf16x8* kf, lds_cptr kp) {
    kf[0] = *(const __attribute__((address_space(3))) bf16x8*)(kp);        kf[1] = *(const __attribute__((address_space(3))) bf16x8*)(kp + 512);
    kf[2] = *(const __attribute__((address_space(3))) bf16x8*)(kp + 2048); kf[3] = *(const __attribute__((address_space(3))) bf16x8*)(kp + 2560);
    kf[4] = *(const __attribute__((address_space(3))) bf16x8*)(kp + 4096); kf[5] = *(const __attribute__((address_space(3))) bf16x8*)(kp + 4608);
    kf[6] = *(const __attribute__((address_space(3))) bf16x8*)(kp + 6144); kf[7] = *(const __attribute__((address_space(3))) bf16x8*)(kp + 6656);
}
__device__ __forceinline__ void kload2(bf16x8* kf, lds_cptr kp, int j) { kf[2 * j] = *(const __attribute__((address_space(3))) bf16x8*)(kp + j * 2048); kf[2 * j + 1] = *(const __attribute__((address_space(3))) bf16x8*)(kp + j * 2048 + 512); }
__device__ __forceinline__ s16x4 vtr(lds_cptr p) { return __builtin_bit_cast(s16x4, __builtin_amdgcn_ds_read_tr16_b64_v4i16((__attribute__((address_space(3))) v4i16_t*)p)); }
__device__ __forceinline__ float rowmax(const f32x16& p0, const f32x16& p1) {
    float a = max3f(p0[0], p0[1], p1[0]), b = max3f(p0[2], p0[3], p1[1]); a = max3f(a, p1[2], p1[3]);
#pragma unroll
    for (int r = 4; r < 16; r += 4) { a = max3f(a, p0[r], p0[r + 1]); b = max3f(b, p0[r + 2], p0[r + 3]); a = max3f(a, p1[r], p1[r + 1]); b = max3f(b, p1[r + 2], p1[r + 3]); }
    const float m = max2f(a, b);
    auto rr = __builtin_amdgcn_permlane32_swap(__float_as_uint(m), __float_as_uint(m), false, false);
    return max2f(__uint_as_float(rr[0]), __uint_as_float(rr[1]));
}
__device__ __forceinline__ void pv(f32x16* o, int vb, bf16x8 pa0, bf16x8 pa1, bf16x8 pa2, bf16x8 pa3) {
#pragma unroll
    for (int d0 = 0; d0 < 2; ++d0) { s16x4 lo[4], hi[4];
#pragma unroll
        for (int ks = 0; ks < 4; ++ks) {
            asm volatile("ds_read_b64_tr_b16 %0,%1 offset:%c2" : "=&v"(lo[ks]) : "v"(vb), "i"(d0 * 4096 + ks * 1024) : "memory");
            asm volatile("ds_read_b64_tr_b16 %0,%1 offset:%c2" : "=&v"(hi[ks]) : "v"(vb), "i"(d0 * 4096 + ks * 1024 + 512) : "memory"); }
        asm volatile("s_waitcnt lgkmcnt(0)" ::: "memory"); SBAR();
#define PK(k) (bf16x8){lo[k][0], lo[k][1], lo[k][2], lo[k][3], hi[k][0], hi[k][1], hi[k][2], hi[k][3]}
        o[d0] = __builtin_amdgcn_mfma_f32_32x32x16_bf16(pa0, PK(0), o[d0], 0, 0, 0);
        o[d0] = __builtin_amdgcn_mfma_f32_32x32x16_bf16(pa1, PK(1), o[d0], 0, 0, 0);
        o[d0] = __builtin_amdgcn_mfma_f32_32x32x16_bf16(pa2, PK(2), o[d0], 0, 0, 0);
        o[d0] = __builtin_amdgcn_mfma_f32_32x32x16_bf16(pa3, PK(3), o[d0], 0, 0, 0);
#undef PK
    }
}

template <int THRL, bool CAUSAL, bool BIAS, int QP, int KP, int OP>
__device__ __forceinline__ void attn_unit(const bf16* Qb, const bf16* __restrict__ Kh, const bf16* __restrict__ Vh, bf16* Ob, const float* biasg, const float* ttg, const int NT, char* shm) {
    int tid_o = threadIdx.x; asm volatile("" : "+v"(tid_o));
    const int tid = tid_o, lane = tid & 63, r32 = lane & 31, hi = lane >> 5; const int wid = __builtin_amdgcn_readfirstlane(tid >> 6);
    const bf16* Qw = Qb + (long)(wid * QBLK) * QP;
    const unsigned lds0 = (unsigned)(uintptr_t)shm;
    float* wsf = (float*)(shm + LDS_WS) + wid * 64;
    const bf16* ksrc = Kh + (long)lane * KP + wid * 8;
    const bf16* vsrc = Vh + (long)(16 * (wid & 3) + (lane >> 2)) * KP + (wid >> 2) * 32 + (lane & 3) * 8;
    const unsigned kdst = lds0 + LDS_K + wid * 1024, vdst = lds0 + LDS_V + wid * 1024;
#define DMA_K(t, slot) glds16(ksrc + (long)(t) * KVBLK * KP, (unsigned)__builtin_amdgcn_readfirstlane(kdst + (slot)))
#define DMA_V(t, slot) glds16(vsrc + (long)(t) * KVBLK * KP, (unsigned)__builtin_amdgcn_readfirstlane(vdst + (slot)))
    const int vb0 = (int)(lds0 + LDS_V) + ((lane >> 4) & 1) * 32 + (lane & 3) * 8 + (4 * hi + ((lane & 15) >> 2)) * 64;
    const char* Kbase = shm + LDS_K; bf16x8 kf[8];
    const lds_cptr shm3 = (lds_cptr)shm; const lds_cptr kp0 = shm3 + LDS_K + hi * 1024 + r32 * 16; const lds_cptr vp0 = shm3 + LDS_V + ((lane >> 4) & 1) * 32 + (lane & 3) * 8 + (4 * hi + ((lane & 15) >> 2)) * 64;
    const __attribute__((address_space(3))) s16x4* biasx = (const __attribute__((address_space(3))) s16x4*)(shm3 + LDS_BIAS) + r32;
    s16x4 qx; { const short one = hi ? (short)0 : (short)0x3F80; qx = (s16x4){one, one, one, (short)0}; }
    if (BIAS) {
        __attribute__((address_space(3))) u32x4* bl = (__attribute__((address_space(3))) u32x4*)(shm3 + LDS_BIAS);
        for (int i = tid; i < NT * 16; i += NW * 64) { const f32x4 v = *(const f32x4*)(biasg + 4 * i); const int tile = i >> 6; float pre = 0.f;
#pragma unroll
            for (int t = 0; t < 15; ++t) { const float x = ttg[12 * t]; pre += (t < tile) ? x : 0.f; }
            const f32x4 bv = (v + pre) * (-LOG2E);
            unsigned w[8];
#pragma unroll
            for (int j = 0; j < 4; ++j) { const float x = bv[j]; const unsigned hb = cvtpk_s(x, 0.f) & 0xffffu; const float r1 = x - __uint_as_float(hb << 16);
                const unsigned mb = cvtpk_s(r1, 0.f) & 0xffffu; const float r2 = r1 - __uint_as_float(mb << 16); const unsigned lb = cvtpk_s(r2, 0.f) & 0xffffu;
                w[2 * j] = hb | (mb << 16); w[2 * j + 1] = lb; }
            bl[2 * i] = (u32x4){w[0], w[1], w[2], w[3]}; bl[2 * i + 1] = (u32x4){w[4], w[5], w[6], w[7]}; }
    }
    DMA_K(0, 0); DMA_V(0, 0); DMA_K(1, SLOTB);
    bf16x8 qr[4];
#pragma unroll
    for (int d0 = 0; d0 < 4; ++d0) qr[d0] = *reinterpret_cast<const bf16x8*>(&Qw[(long)r32 * QP + d0 * 16 + hi * 8]);
    float mhat = 0.f, l_reg = 0.f; f32x16 o[2]; f32x16 negm;
    { float zf = 0.f; asm volatile("" : "+v"(zf));
#pragma unroll
      for (int r = 0; r < 16; ++r) { o[0][r] = zf; o[1][r] = zf; negm[r] = zf; } }
    asm volatile("" : "+v"(negm));
    const int qrel = wid * QBLK + r32;
#define CMASK(P0, P1, t) do { if (CAUSAL) { int jb_ = (t) - (NT - 4); if (jb_ >= 0) cmask(P0, P1, jb_, qrel, hi); } } while (0)
    s16x4 ax0, ax1;
#define AXRD(G, t) do { if (BIAS && (G)) { ax0 = biasx[(t) * 64]; ax1 = biasx[(t) * 64 + 32]; } } while (0)
#define BMF(C, AX) __builtin_amdgcn_mfma_f32_32x32x8bf16_1k(AX, qx, C, 0, 0, 0)
    bool resc = false;
#define START(P0, P1) do { const float rm = rowmax(P0, P1); resc = false; \
    { const float dl = rm; mhat = fadd_s(mhat, dl); \
      _Pragma("unroll") for (int r = 0; r < 16; ++r) { P0[r] = fsub_s(P0[r], dl); P1[r] = fsub_s(P1[r], dl); } \
      _Pragma("unroll") for (int r = 0; r < 16; ++r) negm[r] = -mhat; asm volatile("" : "+v"(negm)); } \
    _Pragma("unroll") for (int r = 0; r < 16; ++r) P0[r] = __builtin_amdgcn_exp2f(P0[r]); } while (0)
#define RESC() do { if (resc) { asm volatile("s_waitcnt lgkmcnt(0)" ::: "memory"); \
      _Pragma("unroll") for (int d_ = 0; d_ < 2; ++d_) _Pragma("unroll") for (int r = 0; r < 16; ++r) o[d_][r] *= wsf[crow(r, hi)]; } } while (0)
    f32x16 pA0, pA1, pB0, pB1;
    int sl_prev = 0, sl_cur = 0, sl_next = SLOTB;
#define ROT() do { sl_prev = sl_cur; sl_cur = sl_next; sl_next = (sl_next == (NSLOT - 1) * SLOTB) ? 0 : sl_next + SLOTB; } while (0)
    DMA_K(2, 2 * SLOTB);
    WAIT_BAR(3);
    qkt(pA0, pA1, Kbase, qr, negm, r32, hi); if (BIAS) { AXRD(true, 0); pA0 = BMF(pA0, ax0); pA1 = BMF(pA1, ax1); } asm volatile("s_nop 15\n\ts_nop 7" : "+v"(pA0), "+v"(pA1)); CMASK(pA0, pA1, 0);
    START(pA0, pA1);
    _Pragma("unroll") for (int r = 0; r < 16; ++r) pA1[r] = __builtin_amdgcn_exp2f(pA1[r]);
    WAIT_BAR(0);
    DMA_K(3, 0); DMA_V(1, SLOTB);
    ROT();
    kload8(kf, kp0 + sl_cur); AXRD(true, 1);
    WAIT_BAR(2);
    s16x4 vlo[8], vhi[8]; u32x4 pw0, pw1, pw2, pw3;
#define PKW(P, B) cvtpk_s(P[B], P[B + 1])
#define PAF(k) __builtin_bit_cast(bf16x8, pw##k)
#define VFR(i) (bf16x8){vlo[i][0], vlo[i][1], vlo[i][2], vlo[i][3], vhi[i][0], vhi[i][1], vhi[i][2], vhi[i][3]}
#define PIN(x) asm volatile("" : "+v"(x))
#define MX3(a, b, c) __builtin_fmaxf(__builtin_fmaxf((a), (b)), (c))
#define GAPA(MF, A0, A1, A2, A3, W0, W1, PW) do { MF; sacc += A0; sacc += A1; sacc += A2; sacc += A3; PIN(sacc); W0; W1; PIN(PW); SBAR(); } while (0)
#define EX(v) __builtin_amdgcn_exp2f(v)
#define GAPB(MF, X, B) do { MF; X[B] = EX(X[B]); X[B + 1] = EX(X[B + 1]); X[B + 2] = EX(X[B + 2]); X[B + 3] = EX(X[B + 3]); PIN(X); SBAR(); } while (0)
#define VRD(i) do { vlo[i] = vtr(vp_ + (((i) >> 2) * 4096 + ((i) & 3) * 1024)); vhi[i] = vtr(vp_ + (((i) >> 2) * 4096 + ((i) & 3) * 1024 + 512)); } while (0)
#define KRD(G, j) do { if (G) { kload2(kf, kp0 + sl_next, j); SBAR(); } } while (0)
#define STEP(C0, C1, P0, P1, t, GK, GV, GL) do { SBAR(); \
    const lds_cptr vp_ = vp0 + sl_prev; \
    VRD(0); SBAR(); float sacc = (P0[0] + P0[1]); \
    if (BIAS) { C0 = BMF(negm, ax0); SBAR(); C1 = BMF(negm, ax1); SBAR(); } \
    GAPA(C0 = __builtin_amdgcn_mfma_f32_32x32x16_bf16(kf[0], qr[0], BIAS ? C0 : negm, 0, 0, 0), P0[2], P0[3], P0[4], P0[5],     pw0[0] = PKW(P0, 0), pw0[1] = PKW(P0, 2), pw0); \
    VRD(4); SBAR(); GAPA(C1 = __builtin_amdgcn_mfma_f32_32x32x16_bf16(kf[1], qr[0], BIAS ? C1 : negm, 0, 0, 0), P0[6], P0[7], P0[8], P0[9],     pw0[2] = PKW(P0, 4), pw0[3] = PKW(P0, 6), pw0); \
    VRD(1); SBAR(); GAPA(C0 = __builtin_amdgcn_mfma_f32_32x32x16_bf16(kf[2], qr[1], C0, 0, 0, 0),   P0[10], P0[11], P0[12], P0[13], pw1[0] = PKW(P0, 8), pw1[1] = PKW(P0, 10), pw1); \
    VRD(5); SBAR(); GAPA(C1 = __builtin_amdgcn_mfma_f32_32x32x16_bf16(kf[3], qr[1], C1, 0, 0, 0),   P0[14], P0[15], P1[0], P1[1],   pw1[2] = PKW(P0, 12), pw1[3] = PKW(P0, 14), pw1); \
    VRD(2); SBAR(); GAPA(C0 = __builtin_amdgcn_mfma_f32_32x32x16_bf16(kf[4], qr[2], C0, 0, 0, 0),   P1[2], P1[3], P1[4], P1[5],     pw2[0] = PKW(P1, 0), pw2[1] = PKW(P1, 2), pw2); \
    VRD(6); SBAR(); GAPA(C1 = __builtin_amdgcn_mfma_f32_32x32x16_bf16(kf[5], qr[2], C1, 0, 0, 0),   P1[6], P1[7], P1[8], P1[9],     pw2[2] = PKW(P1, 4), pw2[3] = PKW(P1, 6), pw2); \
    VRD(3); SBAR(); GAPA(C0 = __builtin_amdgcn_mfma_f32_32x32x16_bf16(kf[6], qr[3], C0, 0, 0, 0),   P1[10], P1[11], P1[12], P1[13], pw3[0] = PKW(P1, 8), pw3[1] = PKW(P1, 10), pw3); \
    VRD(7); SBAR(); GAPA(C1 = __builtin_amdgcn_mfma_f32_32x32x16_bf16(kf[7], qr[3], C1, 0, 0, 0),   P1[14], P1[15], 0.f, 0.f,       pw3[2] = PKW(P1, 12), pw3[3] = PKW(P1, 14), pw3); \
    l_reg += sacc; \
    if (GK) { DMA_K((t) + 3, sl_cur); } if (GV) { DMA_V((t) + 1, sl_next); } \
    CMASK(C0, C1, t); \
    { float a = MX3(C0[0], C0[1], C1[0]), b = MX3(C0[2], C0[3], C1[1]); a = MX3(a, C1[2], C1[3]); \
      _Pragma("unroll") for (int r = 4; r < 16; r += 4) { a = MX3(a, C0[r], C0[r + 1]); b = MX3(b, C0[r + 2], C0[r + 3]); a = MX3(a, C1[r], C1[r + 1]); b = MX3(b, C1[r + 2], C1[r + 3]); } \
      float rm = __builtin_fmaxf(a, b); { auto rr = __builtin_amdgcn_permlane32_swap(__float_as_uint(rm), __float_as_uint(rm), false, false); rm = __builtin_fmaxf(__uint_as_float(rr[0]), __uint_as_float(rr[1])); } \
      resc = false; \
      if (__builtin_expect(__any(rm > (float)THRL), 0)) { const float dl = __builtin_fmaxf(rm, 0.f); mhat += dl; \
        _Pragma("unroll") for (int r = 0; r < 16; ++r) { C0[r] -= dl; C1[r] -= dl; } \
        _Pragma("unroll") for (int r = 0; r < 16; ++r) negm[r] = -mhat; asm volatile("" : "+v"(negm)); \
        const float f = __builtin_amdgcn_exp2f(-dl); l_reg *= f; if (hi == 0) wsf[r32] = f; resc = true; } } \
    SBAR(); \
    GAPB(o[0] = __builtin_amdgcn_mfma_f32_32x32x16_bf16(PAF(0), VFR(0), o[0], 0, 0, 0), C0, 0); \
    GAPB(o[1] = __builtin_amdgcn_mfma_f32_32x32x16_bf16(PAF(0), VFR(4), o[1], 0, 0, 0), C0, 4); \
    KRD(GL, 0); GAPB(o[0] = __builtin_amdgcn_mfma_f32_32x32x16_bf16(PAF(1), VFR(1), o[0], 0, 0, 0), C0, 8); \
    KRD(GL, 1); GAPB(o[1] = __builtin_amdgcn_mfma_f32_32x32x16_bf16(PAF(1), VFR(5), o[1], 0, 0, 0), C0, 12); \
    KRD(GL, 2); GAPB(o[0] = __builtin_amdgcn_mfma_f32_32x32x16_bf16(PAF(2), VFR(2), o[0], 0, 0, 0), C1, 0); \
    KRD(GL, 3); GAPB(o[1] = __builtin_amdgcn_mfma_f32_32x32x16_bf16(PAF(2), VFR(6), o[1], 0, 0, 0), C1, 4); \
    AXRD(GL, (t) + 1); if (BIAS && (GL)) SBAR(); \
    GAPB(o[0] = __builtin_amdgcn_mfma_f32_32x32x16_bf16(PAF(3), VFR(3), o[0], 0, 0, 0), C1, 8); \
    GAPB(o[1] = __builtin_amdgcn_mfma_f32_32x32x16_bf16(PAF(3), VFR(7), o[1], 0, 0, 0), C1, 12); \
    } while (0)
    int t = 1;
    if (CAUSAL) {
#undef CMASK
#define CMASK(P0, P1, t) do {} while (0)
        for (; t + 5 < NT; t += 2) {
            STEP(pB0, pB1, pA0, pA1, t, true, true, true);     WAIT_BAR(2); RESC(); ROT();
            STEP(pA0, pA1, pB0, pB1, t + 1, true, true, true); WAIT_BAR(2); RESC(); ROT();
        }
#undef CMASK
#define CMASK(P0, P1, t) do { if (CAUSAL) { int jb_ = (t) - (NT - 4); if (jb_ >= 0) cmask(P0, P1, jb_, qrel, hi); } } while (0)
    }
#define ENDW(tt) do { if ((tt) + 3 < NT) { WAIT_BAR(2); } else if ((tt) + 2 < NT) { WAIT_BAR(1); } else { WAIT_BAR(0); } } while (0)
    for (; t + 1 < NT; t += 2) {
        STEP(pB0, pB1, pA0, pA1, t, (t + 3 < NT), (t + 1 < NT), (t + 1 < NT));         ENDW(t);     RESC(); ROT();
        STEP(pA0, pA1, pB0, pB1, t + 1, (t + 4 < NT), (t + 2 < NT), (t + 2 < NT));     ENDW(t + 1); RESC(); ROT();
    }
    STEP(pB0, pB1, pA0, pA1, NT - 1, false, false, false); RESC();
    { float sacc = pB0[0] + pB0[1]; _Pragma("unroll") for (int r = 2; r < 16; ++r) sacc += pB0[r]; _Pragma("unroll") for (int r = 0; r < 16; ++r) sacc += pB1[r]; l_reg += sacc;
      pw0 = (u32x4){PKW(pB0, 0), PKW(pB0, 2), PKW(pB0, 4), PKW(pB0, 6)}; pw1 = (u32x4){PKW(pB0, 8), PKW(pB0, 10), PKW(pB0, 12), PKW(pB0, 14)}; pw2 = (u32x4){PKW(pB1, 0), PKW(pB1, 2), PKW(pB1, 4), PKW(pB1, 6)}; pw3 = (u32x4){PKW(pB1, 8), PKW(pB1, 10), PKW(pB1, 12), PKW(pB1, 14)};
      SBAR(); pv(o, vb0 + sl_cur, PAF(0), PAF(1), PAF(2), PAF(3)); }
#undef PKW
#undef PAF
#undef VFR
#undef PIN
#undef MX3
#undef GAPA
#undef GAPB
#undef EX
#undef VRD
#undef KRD
#undef STEP
#undef ENDW
    { auto rr = __builtin_amdgcn_permlane32_swap(__float_as_uint(l_reg), __float_as_uint(l_reg), false, false); l_reg = __uint_as_float(rr[0]) + __uint_as_float(rr[1]); }
    int tid_e = threadIdx.x; asm volatile("" : "+v"(tid_e));
    const int lane_e = tid_e & 63, r32_e = lane_e & 31, hi_e = lane_e >> 5;
    float* wsf_e = (float*)(shm + LDS_WS) + wid * 64;
    if (hi_e == 0) wsf_e[32 + r32_e] = l_reg; asm volatile("s_waitcnt lgkmcnt(0)" ::: "memory");
    float rli[16];
#pragma unroll
    for (int r = 0; r < 16; ++r) rli[r] = __builtin_amdgcn_rcpf(wsf_e[32 + crow(r, hi_e)]);
    bf16* Ow = Ob + (long)(wid * QBLK) * OP;
    { bf16* stg = (bf16*)(shm + LDS_OST) + wid * 2048;
#pragma unroll
      for (int r = 0; r < 16; ++r) { const int orow = crow(r, hi_e);
#pragma unroll
        for (int d0 = 0; d0 < 2; ++d0) stg[orow * 64 + d0 * 32 + r32_e] = __float2bfloat16(o[d0][r] * rli[r]); }
      asm volatile("s_waitcnt lgkmcnt(0)" ::: "memory");
#pragma unroll
      for (int i = 0; i < 4; ++i) { const int row = i * 8 + (lane_e >> 3), ch = lane_e & 7; const u32x4 v = *(const u32x4*)(stg + row * 64 + ch * 8); *(u32x4*)(Ow + (long)row * OP + ch * 8) = v; } }
    asm volatile("s_waitcnt lgkmcnt(0)\n\ts_barrier" ::: "memory");
#undef DMA_K
#undef DMA_V
#undef CMASK
#undef AXRD
#undef BMF
#undef START
#undef RESC
#undef ROT
}
constexpr int ATTN_LDS_BYTES = LDS_BYTES;
#undef SBAR
#undef WAIT_BAR
}

constexpr size_t MiB = 1u << 20;
constexpr size_t WS_CTL = 0, CTL_ZERO_BYTES = 64 * 1024;
constexpr size_t WS_WINA = 2 * MiB;
constexpr size_t WS_WMKV = 6 * MiB;
constexpr size_t WS_WOUT = 8 * MiB;
constexpr size_t WS_WGU = 12 * MiB;
constexpr size_t WS_WDN = 34 * MiB;
constexpr size_t WS_WP1 = 45 * MiB;
constexpr size_t WS_WSP = 51 * MiB;
constexpr size_t WS_MN = 52 * MiB;
constexpr size_t WS_KVM = 54 * MiB;
constexpr size_t WS_VST = 56 * MiB;
constexpr size_t WS_FG = 58 * MiB;
constexpr size_t WS_BIAS = 59 * MiB;
constexpr size_t WS_XS = 60 * MiB;
constexpr size_t WS_XN = 64 * MiB;
constexpr size_t WS_MIX = 96 * MiB;
constexpr size_t WS_H = 128 * MiB;
constexpr size_t WS_U = 128 * MiB, WS_GV = 152 * MiB, WS_QM0 = 176 * MiB;
constexpr size_t WS_Q = 128 * MiB, WS_K = 152 * MiB, WS_V = 176 * MiB, WS_QM1 = 200 * MiB;
constexpr size_t WS_END = 216 * MiB;
constexpr int CW_TMO = 0, CW_CODE = 1, CW_KVM = 2048  , CW_P5D = 2112  , CW_BAR = 4096, CW_SEAM = 16384, SEAM_BANK = 64 * 64;
static_assert((CW_BAR + 3456) * 4 <= (int)CTL_ZERO_BYTES && CW_SEAM * 4 >= (int)CTL_ZERO_BYTES, "barrier words inside the memset region, panel counters above it");
constexpr int CW_GRP = CW_SEAM + 8 * SEAM_BANK;
constexpr int CW_XCC = CW_GRP + 64 * 8 * 64;
static_assert((CW_XCC + 256) * 4 <= 2 * 1024 * 1024, "control words below the first weight buffer");

constexpr int RING_OFF = 0, RING_BYTES = 131072;
constexpr int LDSCTL_OFF = RING_BYTES, MISC_OFF = LDSCTL_OFF + 320;
constexpr int RTAB_OFF = LDSCTL_OFF + 512, RTAB_UNITS = 6;
constexpr int LDS_BYTES = 147456;
static_assert(RTAB_OFF + RTAB_UNITS * 1024 + 256 <= LDS_BYTES, "LDS map");
static_assert(MISC_OFF + 128 <= LDS_BYTES, "LDS map");
static_assert(attn_body::ATTN_LDS_BYTES <= RING_BYTES, "attention scratch inside the ring region");

#define GAS __attribute__((address_space(1)))
#define LAS __attribute__((address_space(3)))
typedef unsigned short bf16;
typedef unsigned v4u __attribute__((ext_vector_type(4)));
typedef float f32x4 __attribute__((ext_vector_type(4)));
typedef float f32x2 __attribute__((ext_vector_type(2)));
typedef float f32x16 __attribute__((ext_vector_type(16)));
typedef short bf16x8 __attribute__((ext_vector_type(8)));
typedef GAS unsigned gu32;
#define RLX_AGENT __ATOMIC_RELAXED, __HIP_MEMORY_SCOPE_AGENT
#define LDS_WAIT() asm volatile("s_waitcnt lgkmcnt(0)" ::: "memory")
#define VM_WAIT() asm volatile("s_waitcnt vmcnt(0)" ::: "memory")
__device__ __forceinline__ unsigned f2bf(float f) { unsigned u = __builtin_bit_cast(unsigned, f); return (u + 0x7fffu + ((u >> 16) & 1u)) >> 16; }
__device__ __forceinline__ unsigned pk2(float lo, float hi) { typedef float f2_t __attribute__((ext_vector_type(2))); typedef __bf16 b2_t __attribute__((ext_vector_type(2))); f2_t v = {lo, hi}; b2_t b = __builtin_convertvector(v, b2_t); return __builtin_bit_cast(unsigned, b); }
__device__ __forceinline__ float bf2f(unsigned short h) { return __uint_as_float((unsigned)h << 16); }

#define XB_TMO      128
#define XB_XCNT(j)  (256  + 64 * (j))
#define XB_XSUB(j)  (1280 + 64 * (j))
#define XB_XGEN(j)  (2304 + 64 * (j))
#define XB_TOP      3328
#define XB_TOPGEN   3392
#define XCD_BAR_WORDS 3456
#define XB_SPIN_CAP (1u << 18)
__device__ __forceinline__ unsigned xb_ld(unsigned* p)              { return __hip_atomic_load(p, __ATOMIC_RELAXED, __HIP_MEMORY_SCOPE_AGENT); }
__device__ __forceinline__ unsigned xb_add(unsigned* p, unsigned v) { return __hip_atomic_fetch_add(p, v, __ATOMIC_RELAXED, __HIP_MEMORY_SCOPE_AGENT); }
__device__ __forceinline__ unsigned xb_xcc_id() { return (unsigned)__builtin_amdgcn_s_getreg((3 << 11) | 20) & 0xFu; }
#define XB_SPIN(cond, bar) do { unsigned _sp = 0; while (cond) { __builtin_amdgcn_s_sleep(1); \
    if ((++_sp & 255u) == 0u) { if (xb_ld(&(bar)[XB_TMO])) break; if (_sp > XB_SPIN_CAP) { atomicAdd(&(bar)[XB_TMO], 1u); break; } } } } while (0)
struct XcdBarrier { unsigned* bar; unsigned x; volatile LAS unsigned* st; };
__device__ __forceinline__ XcdBarrier xcd_barrier_post(unsigned* bar, volatile LAS unsigned* st) {
    XcdBarrier b; b.bar = bar; b.x = xb_xcc_id(); b.st = st;
    if (threadIdx.x == 0) (void)xb_add(&bar[XB_XCNT(b.x)], 1u);
    return b;
}
__device__ __forceinline__ void xcd_barrier_complete(unsigned* bar, unsigned x, unsigned& nloc, unsigned& nx) {
    const unsigned G = gridDim.x * gridDim.y * gridDim.z;
    unsigned sum, cnt, mine, sp = 0u;
    for (;;) {
        sum = 0u; cnt = 0u; mine = 0u;
#pragma unroll
        for (unsigned j = 0; j < 16; ++j) { const unsigned c = xb_ld(&bar[XB_XCNT(j)]); sum += c; cnt += (c > 0u) ? 1u : 0u; mine = (j == x) ? c : mine; }
        if (sum == G) break;
        __builtin_amdgcn_s_sleep(1);
        if ((++sp & 255u) == 0u) { if (xb_ld(&bar[XB_TMO])) break; if (sp > XB_SPIN_CAP) { atomicAdd(&bar[XB_TMO], 1u); break; } }
    }
    nloc = mine > 0u ? mine : 1u; nx = cnt > 0u ? cnt : 1u;
}
__device__ __attribute__((noinline)) void xcd_barrier_fn(GAS unsigned* bar_, unsigned x_, volatile LAS unsigned* st_) {
    XcdBarrier b; b.bar = (unsigned*)bar_; b.x = x_; b.st = st_;
    asm volatile("s_waitcnt vmcnt(0)" ::: "memory");
    __syncthreads();
    if (threadIdx.x == 0) {
        unsigned* bar = b.bar;
        __builtin_amdgcn_s_waitcnt(0);
        unsigned nloc = b.st[0], nx = b.st[1];
        if (nloc == 0u) { xcd_barrier_complete(bar, b.x, nloc, nx); b.st[0] = nloc; b.st[1] = nx; }
        const unsigned old = xb_add(&bar[XB_XSUB(b.x)], 1u);
        const unsigned gen = old / nloc;
        if (old + 1u == (gen + 1u) * nloc) {
            __builtin_amdgcn_fence(__ATOMIC_RELEASE, "agent");
            asm volatile("s_waitcnt vmcnt(0)" ::: "memory");
            const unsigned og = xb_add(&bar[XB_TOP], 1u);
            const unsigned tg = og / nx;
            if (og + 1u == (tg + 1u) * nx) xb_add(&bar[XB_TOPGEN], 1u);
            else XB_SPIN(xb_ld(&bar[XB_TOPGEN]) == tg, bar);
            __builtin_amdgcn_fence(__ATOMIC_ACQUIRE, "agent");
            xb_add(&bar[XB_XGEN(b.x)], 1u);
            asm volatile("s_waitcnt vmcnt(0)" ::: "memory");
        } else {
            XB_SPIN(xb_ld(&bar[XB_XGEN(b.x)]) == gen, bar);
            __builtin_amdgcn_fence(__ATOMIC_ACQUIRE, "agent");
            asm volatile("s_waitcnt vmcnt(0)" ::: "memory");
        }
    }
    __syncthreads();
}

__device__ __attribute__((noinline)) void group_barrier_fn(GAS unsigned* word_, int same_xcd, GAS unsigned* tmo_) {
    unsigned* word = (unsigned*)word_; unsigned* tmo = (unsigned*)tmo_;
    asm volatile("s_waitcnt vmcnt(0)" ::: "memory");
    __syncthreads();
    if (threadIdx.x == 0) {
        __builtin_amdgcn_s_waitcnt(0);
        if (!same_xcd) { __builtin_amdgcn_fence(__ATOMIC_RELEASE, "agent"); asm volatile("s_waitcnt vmcnt(0)" ::: "memory"); }
        (void)xb_add(word, 1u);
        unsigned sp = 0u;
        while (xb_ld(word) < 4u) { __builtin_amdgcn_s_sleep(1); if ((++sp & 255u) == 0u) { if (xb_ld(tmo)) break; if (sp > XB_SPIN_CAP) { atomicAdd(tmo, 1u); break; } } }
        __builtin_amdgcn_fence(__ATOMIC_ACQUIRE, "agent");
        asm volatile("s_waitcnt vmcnt(0)" ::: "memory");
    }
    __syncthreads();
}

constexpr int NWAVES = 8;
struct Args { const float* in[21]; float* out; unsigned char* ws; };
enum { I_X = 0, I_MEM, I_LN_MIX_PRE, I_LN_MIX_POST, I_LN_FFN_PRE, I_LN_FFN_POST, I_LN_MEM, I_W_MEM_KV, I_W_OUT, I_W_GATE, I_W_UP, I_W_DOWN, I_W_IN_A, I_W_SP, I_B_SP, I_LN_V_G, I_LN_V_B, I_LN_SHARED, I_W_SKV, I_B_FORGET, I_W_IN_B };

__device__ __forceinline__ float wave_sum(float v) {
#pragma unroll
    for (int o = 1; o < 64; o <<= 1) v += __shfl_xor(v, o);
    return v;
}
__device__ __forceinline__ void p0_item(const float* W, int ldw, const float* gain, bf16* WT, int Kp, int drow, int k0, int n0, LAS float* scr, int lane) {
#pragma unroll 8
    for (int i = 0; i < 32; ++i) { const int kk = 2 * i + (lane >> 5); float v = W[(size_t)(k0 + kk) * ldw + n0 + (lane & 31)]; if (gain) v *= gain[k0 + kk]; scr[kk * 33 + (lane & 31)] = v; }
    LDS_WAIT(); asm volatile("" ::: "memory");
    const int c = lane & 7;
#pragma unroll
    for (int j = 0; j < 4; ++j) { const int n = (lane >> 3) + 8 * j; const LAS float* s = scr + (8 * c) * 33 + n;
        v4u o; o.x = pk2(s[0 * 33], s[1 * 33]); o.y = pk2(s[2 * 33], s[3 * 33]); o.z = pk2(s[4 * 33], s[5 * 33]); o.w = pk2(s[6 * 33], s[7 * 33]);
        *(GAS v4u*)(WT + (size_t)(drow + n) * Kp + k0 + 8 * c) = o; }
    LDS_WAIT(); asm volatile("" ::: "memory");
}
__device__ __forceinline__ void rms_row_to_bf16(const float* xrow, bf16* orow, int lane) {
    const GAS f32x4* xr = (const GAS f32x4*)xrow + lane;
    f32x4 v[4]; float s2 = 0.f;
#pragma unroll
    for (int j = 0; j < 4; ++j) { v[j] = xr[64 * j]; s2 += (v[j].x * v[j].x + v[j].y * v[j].y) + (v[j].z * v[j].z + v[j].w * v[j].w); }
    const float rstd = 1.f / sqrtf(wave_sum(s2) * (1.f / D) + RMS_EPS);
    GAS unsigned long long* o8 = (GAS unsigned long long*)orow + lane;
#pragma unroll
    for (int j = 0; j < 4; ++j) o8[64 * j] = (unsigned long long)pk2(v[j].x * rstd, v[j].y * rstd) | ((unsigned long long)pk2(v[j].z * rstd, v[j].w * rstd) << 32);
}

constexpr int SP_ROWB = 320, SP_VN0 = 0, SP_VN1 = 128 * SP_ROWB, SP_STAT = 2 * 128 * SP_ROWB, SP_STG = SP_STAT + 1024, SP_BYTES = SP_STG + 8 * 4096;
static_assert(SP_BYTES <= RING_BYTES, "spatial scratch inside the ring region");
__device__ __forceinline__ void spatial_chunk(LAS unsigned char* lds, int bc, int g0, const bf16* U, const bf16* GV, const float* vst, const bf16* Wsp, const float* bsp, const float* lng, const float* lnb, bf16* MIX) {
    int tid_o = threadIdx.x; asm volatile("" : "+v"(tid_o));
    const int tid = tid_o, lane = tid & 63, r32 = lane & 31, hi = lane >> 5; const int wid = __builtin_amdgcn_readfirstlane(tid >> 6);
    const int T0 = bc * CHUNK, tb = wid & 3, dh = wid >> 2, nks = 2 * tb + 2;
    LAS f32x2* STAT = (LAS f32x2*)(lds + SP_STAT);
    const int c = tid & 15, sr = tid >> 4;
    bf16x8 gv[4]; f32x4 ga, gb, ba, bb; bf16x8 af[8]; bf16x8 uu[4];
#define SP_LOAD_GV(g_) do { const int F_ = (g_) * 128 + 8 * c; \
        _Pragma("unroll") for (int j_ = 0; j_ < 4; ++j_) gv[j_] = *(const bf16x8*)(GV + (size_t)(T0 + sr + 32 * j_) * MAINW + F_); \
        ga = *(const f32x4*)(lng + F_); gb = *(const f32x4*)(lng + F_ + 4); ba = *(const f32x4*)(lnb + F_); bb = *(const f32x4*)(lnb + F_ + 4); } while (0)
#define SP_LOAD_W(g_) do { _Pragma("unroll") for (int ks_ = 0; ks_ < 8; ++ks_) { af[ks_] = (bf16x8){0, 0, 0, 0, 0, 0, 0, 0}; if (ks_ < nks) af[ks_] = *(const bf16x8*)(Wsp + (size_t)((g_) * 128 + 32 * tb + r32) * 128 + 16 * ks_ + 8 * hi); } } while (0)
#define SP_LOAD_U(g_) do { _Pragma("unroll") for (int d0_ = 0; d0_ < 2; ++d0_) _Pragma("unroll") for (int h_ = 0; h_ < 2; ++h_) \
        uu[d0_ * 2 + h_] = *(const bf16x8*)(U + (size_t)(T0 + 32 * tb + (lane >> 1)) * MAINW + (g_) * 128 + 64 * dh + 32 * d0_ + 16 * (lane & 1) + 8 * h_); } while (0)
    f32x4 sq[6];
    if (tid < 128) {
#pragma unroll
        for (int i = 0; i < 6; ++i) sq[i] = ((const f32x4*)(vst + (size_t)(T0 + tid) * 24))[i];
    }
    SP_LOAD_GV(g0); SP_LOAD_W(g0);
    if (tid < 128) {
        float s = 0.f, q = 0.f;
#pragma unroll
        for (int i = 0; i < 6; ++i) { s += sq[i].x + sq[i].z; q += sq[i].y + sq[i].w; }
        const float mean = s * (1.f / MAINW); const float var = fmaxf(q * (1.f / MAINW) - mean * mean, 0.f);
        STAT[tid] = (f32x2){mean, 1.0f / sqrtf(var + LN_EPS)};
    }
    LDS_WAIT(); __syncthreads();
    f32x2 st[4];
#pragma unroll
    for (int j = 0; j < 4; ++j) st[j] = STAT[sr + 32 * j];
    LAS float* stg = (LAS float*)(lds + SP_STG + wid * 4096);
#pragma unroll 1
    for (int gi = 0; gi < 3; ++gi) {
        const int g = g0 + gi; LAS unsigned char* vnb = lds + ((gi & 1) ? SP_VN1 : SP_VN0);
#pragma unroll
        for (int j = 0; j < 4; ++j) { float x[8];
#pragma unroll
            for (int e = 0; e < 8; ++e) x[e] = (bf2f((unsigned short)gv[j][e]) - st[j].x) * st[j].y;
            v4u o; o.x = pk2(x[0] * ga.x + ba.x, x[1] * ga.y + ba.y); o.y = pk2(x[2] * ga.z + ba.z, x[3] * ga.w + ba.w); o.z = pk2(x[4] * gb.x + bb.x, x[5] * gb.y + bb.y); o.w = pk2(x[6] * gb.z + bb.z, x[7] * gb.w + bb.w);
            *(LAS v4u*)(vnb + (sr + 32 * j) * SP_ROWB + c * 16) = o; }
        if (gi < 2) SP_LOAD_GV(g + 1);
        SP_LOAD_U(g);
        const float bias = bsp[g * 128 + 32 * tb + (lane >> 1)];
        LDS_WAIT(); __syncthreads();
        f32x16 o[2]; o[0] = f32x16{}; o[1] = f32x16{};
        { const unsigned vb = (unsigned)(uintptr_t)vnb + (unsigned)((8 * hi + ((lane & 15) >> 2)) * SP_ROWB + (64 * dh + 16 * ((lane >> 4) & 1) + 4 * (lane & 3)) * 2);
#pragma unroll
          for (int ks = 0; ks < 8; ++ks) {
            if (ks < nks) {
                attn_body::s16x4 lo[2], hh[2];
#pragma unroll
                for (int d0 = 0; d0 < 2; ++d0) {
                    asm volatile("ds_read_b64_tr_b16 %0,%1 offset:%c2" : "=&v"(lo[d0]) : "v"(vb), "i"(ks * 16 * SP_ROWB + d0 * 64) : "memory");
                    asm volatile("ds_read_b64_tr_b16 %0,%1 offset:%c2" : "=&v"(hh[d0]) : "v"(vb), "i"(ks * 16 * SP_ROWB + 4 * SP_ROWB + d0 * 64) : "memory"); }
                asm volatile("s_waitcnt lgkmcnt(0)" ::: "memory"); __builtin_amdgcn_sched_barrier(0);
#pragma unroll
                for (int d0 = 0; d0 < 2; ++d0) { const bf16x8 bfr = (bf16x8){lo[d0][0], lo[d0][1], lo[d0][2], lo[d0][3], hh[d0][0], hh[d0][1], hh[d0][2], hh[d0][3]};
                    o[d0] = __builtin_amdgcn_mfma_f32_32x32x16_bf16(af[ks], bfr, o[d0], 0, 0, 0); }
            }
          } }
        if (gi < 2) SP_LOAD_W(g + 1);
#pragma unroll
        for (int d0 = 0; d0 < 2; ++d0) {
#pragma unroll
            for (int r = 0; r < 16; ++r) stg[attn_body::crow(r, hi) * 32 + r32] = o[d0][r];
            LDS_WAIT(); asm volatile("" ::: "memory");
            const LAS f32x4* sp = (const LAS f32x4*)(stg + (lane >> 1) * 32 + 16 * (lane & 1));
            const f32x4 a0 = sp[0], a1 = sp[1], a2 = sp[2], a3 = sp[3];
            const bf16x8 u0 = uu[d0 * 2], u1 = uu[d0 * 2 + 1];
            v4u w0, w1;
            w0.x = pk2(bf2f((unsigned short)u0[0]) * (a0.x + bias), bf2f((unsigned short)u0[1]) * (a0.y + bias)); w0.y = pk2(bf2f((unsigned short)u0[2]) * (a0.z + bias), bf2f((unsigned short)u0[3]) * (a0.w + bias));
            w0.z = pk2(bf2f((unsigned short)u0[4]) * (a1.x + bias), bf2f((unsigned short)u0[5]) * (a1.y + bias)); w0.w = pk2(bf2f((unsigned short)u0[6]) * (a1.z + bias), bf2f((unsigned short)u0[7]) * (a1.w + bias));
            w1.x = pk2(bf2f((unsigned short)u1[0]) * (a2.x + bias), bf2f((unsigned short)u1[1]) * (a2.y + bias)); w1.y = pk2(bf2f((unsigned short)u1[2]) * (a2.z + bias), bf2f((unsigned short)u1[3]) * (a2.w + bias));
            w1.z = pk2(bf2f((unsigned short)u1[4]) * (a3.x + bias), bf2f((unsigned short)u1[5]) * (a3.y + bias)); w1.w = pk2(bf2f((unsigned short)u1[6]) * (a3.z + bias), bf2f((unsigned short)u1[7]) * (a3.w + bias));
            bf16* dst = MIX + (size_t)(T0 + 32 * tb + (lane >> 1)) * D + g * 128 + 64 * dh + 32 * d0 + 16 * (lane & 1);
            *(v4u*)dst = w0; *(v4u*)(dst + 8) = w1;
            LDS_WAIT(); asm volatile("" ::: "memory");
        }
    }
    LDS_WAIT(); __syncthreads();
#undef SP_LOAD_GV
#undef SP_LOAD_W
#undef SP_LOAD_U
}

template <class SchedX>
__device__ __forceinline__ void build_rtab(LAS unsigned char* lds, const SchedX& S, const float* ssq) {
    int tid = threadIdx.x; asm volatile("" : "+v"(tid));
    LAS float* tab = (LAS float*)(lds + RTAB_OFF);
    if (tid < 256) {
        f32x4 sq[RTAB_UNITS]; bool ok[RTAB_UNITS];
#pragma unroll
        for (int i = 0; i < RTAB_UNITS; ++i) { pg8::Unit u; u.pm = 0; ok[i] = S.next(i, u); sq[i] = *(const f32x4*)(ssq + (size_t)((ok[i] ? u.pm : 0) * 256 + tid) * 4); }
#pragma unroll
        for (int i = 0; i < RTAB_UNITS; ++i) if (ok[i]) tab[i * 256 + tid] = 1.0f / sqrtf(((sq[i][0] + sq[i][1]) + (sq[i][2] + sq[i][3])) * (1.0f / 1024.0f) + RMS_EPS);
    }
    LDS_WAIT(); __syncthreads();
}

__device__ const unsigned char FOX_TAB[16][3] = {{15, 8, 0}, {31, 24, 16}, {47, 40, 32}, {14, 7, 1}, {30, 23, 17}, {46, 39, 33}, {13, 6, 3}, {29, 22, 19}, {45, 5, 4}, {12, 9, 2}, {28, 38, 20}, {44, 21, 37}, {11, 10, 18}, {27, 26, 34}, {43, 25, 35}, {42, 41, 36}};

constexpr int CV_INA = 16 * 56, CV_MKV = 16 * 16, CV_OUT = 16 * 32, CV_GT = 16 * 88, CV_DN = 44 * 32, CV_INB = 16 * 32, CV_SKV = 16 * 48;
constexpr int CV_LB = CV_OUT + 2 * CV_GT + CV_DN;
constexpr int CV_STAGE_A = CV_INA + 2 * CV_MKV + CV_LB;
constexpr int CV_NITEMS = CV_STAGE_A + CV_LB + CV_INB + CV_SKV;
constexpr int CV_P1W_LO = CV_STAGE_A + CV_LB;
#define CV_DECODE(it_, W_, ldw_, g_, WT_, Kp_, drow_, k0_, n0_) do { int r = (it_); \
        if (r < CV_INA) { const int kb = r / 56, nb = r % 56; W_ = args.in[I_W_IN_A]; ldw_ = N_INA; g_ = args.in[I_LN_MIX_PRE]; WT_ = cv_ina; Kp_ = D; drow_ = 32 * nb; k0_ = 64 * kb; n0_ = 32 * nb; break; } r -= CV_INA; \
        if (r < 2 * CV_MKV) { const int l = r / CV_MKV, q = r % CV_MKV, kb = q / 16, nb = q % 16; W_ = args.in[I_W_MEM_KV] + (size_t)l * D * 512; ldw_ = 512; g_ = args.in[I_LN_MEM] + l * D; WT_ = cv_mkv + (size_t)l * 512 * D; Kp_ = D; drow_ = 32 * nb; k0_ = 64 * kb; n0_ = 32 * nb; break; } r -= 2 * CV_MKV; \
        if (r < 2 * CV_LB) { const int l = r / CV_LB; int q = r % CV_LB; \
            if (q < CV_OUT) { const int kb = q / 32, nb = q % 32; W_ = args.in[I_W_OUT] + (size_t)l * D * D; ldw_ = D; g_ = nullptr; WT_ = cv_out + (size_t)l * D * D; Kp_ = D; drow_ = 32 * nb; k0_ = 64 * kb; n0_ = 32 * nb; break; } q -= CV_OUT; \
            if (q < 2 * CV_GT) { const int up = q / CV_GT, q2 = q % CV_GT, kb = q2 / 88, nb = q2 % 88; W_ = args.in[up ? I_W_UP : I_W_GATE] + (size_t)l * D * FF; ldw_ = FF; g_ = args.in[I_LN_FFN_PRE] + l * D; \
                WT_ = cv_gu + (size_t)l * 2 * FF * D; Kp_ = D; n0_ = 32 * nb; drow_ = (n0_ >> 7) * 256 + (n0_ & 127) + up * 128; k0_ = 64 * kb; break; } q -= 2 * CV_GT; \
            { const int kb = q / 32, nb = q % 32; W_ = args.in[I_W_DOWN] + (size_t)l * FF * D; ldw_ = D; g_ = nullptr; WT_ = cv_dn + (size_t)l * D * FF; Kp_ = FF; drow_ = 32 * nb; k0_ = 64 * kb; n0_ = 32 * nb; break; } } r -= 2 * CV_LB; \
        if (r < CV_INB) { const int kb = r / 32, nb = r % 32; W_ = args.in[I_W_IN_B]; ldw_ = D; g_ = args.in[I_LN_MIX_PRE] + D; WT_ = cv_p1; Kp_ = D; drow_ = 32 * nb; k0_ = 64 * kb; n0_ = 32 * nb; break; } r -= CV_INB; \
        { const int kb = r / 48, nb = r % 48; W_ = args.in[I_W_SKV]; ldw_ = N_SKV; g_ = args.in[I_LN_SHARED]; WT_ = cv_p1; Kp_ = D; drow_ = 1024 + 32 * nb; k0_ = 64 * kb; n0_ = 32 * nb; } } while (0)
#define CV_LOAD(v_, W_, ldw_, k0_, n0_, LANE) do { const float* p_ = (W_) + (size_t)((k0_) + ((LANE) >> 5)) * (ldw_) + (n0_) + ((LANE) & 31); \
        _Pragma("unroll") for (int i_ = 0; i_ < 32; ++i_) v_[i_] = __builtin_nontemporal_load(p_ + (size_t)(2 * i_) * (ldw_)); } while (0)
#define CV_PROC(v_, g_, WT_, Kp_, drow_, k0_, LANE, SCR) do { \
        _Pragma("unroll") for (int i_ = 0; i_ < 32; ++i_) (SCR)[(2 * i_ + ((LANE) >> 5)) * 33 + ((LANE) & 31)] = v_[i_]; \
        LDS_WAIT(); asm volatile("" ::: "memory"); \
        const int c_ = (LANE) & 7; f32x4 ga_ = (f32x4){1.f, 1.f, 1.f, 1.f}, gb_ = ga_; if (g_) { ga_ = *(const f32x4*)((g_) + (k0_) + 8 * c_); gb_ = *(const f32x4*)((g_) + (k0_) + 8 * c_ + 4); } \
        _Pragma("unroll") for (int j_ = 0; j_ < 4; ++j_) { const int n_ = ((LANE) >> 3) + 8 * j_; const LAS float* s_ = (SCR) + (8 * c_) * 33 + n_; \
            v4u o_; o_.x = pk2(s_[0 * 33] * ga_.x, s_[1 * 33] * ga_.y); o_.y = pk2(s_[2 * 33] * ga_.z, s_[3 * 33] * ga_.w); o_.z = pk2(s_[4 * 33] * gb_.x, s_[5 * 33] * gb_.y); o_.w = pk2(s_[6 * 33] * gb_.z, s_[7 * 33] * gb_.w); \
            *(GAS v4u*)((WT_) + (size_t)((drow_) + n_) * (Kp_) + (k0_) + 8 * c_) = o_; } \
        LDS_WAIT(); asm volatile("" ::: "memory"); } while (0)
#define CONVERT_ITEMS(IT0, IT1, GW, NGW_, LANE, SCR) do { \
        bf16* const cv_ina = W_INA; bf16* const cv_mkv = W_MKV; bf16* const cv_out = W_OUT; bf16* const cv_gu = W_GU; bf16* const cv_dn = W_DN; bf16* const cv_p1 = W_P1; \
        const float *Wa = nullptr, *ga = nullptr, *Wb = nullptr, *gb = nullptr; bf16 *Ta = nullptr, *Tb = nullptr; int lda = 0, Ka = 0, dra = 0, k0a = 0, n0a = 0, ldb = 0, Kb = 0, drb = 0, k0b = 0, n0b = 0; \
        float va[32], vb[32]; \
        int it = (IT0) + (GW); \
        if (it < (IT1)) { CV_DECODE(it, Wa, lda, ga, Ta, Ka, dra, k0a, n0a); CV_LOAD(va, Wa, lda, k0a, n0a, LANE); } \
        while (it < (IT1)) { \
            int itn = it + (NGW_); bool hn = itn < (IT1); \
            if (hn) { CV_DECODE(itn, Wb, ldb, gb, Tb, Kb, drb, k0b, n0b); CV_LOAD(vb, Wb, ldb, k0b, n0b, LANE); } \
            CV_PROC(va, ga, Ta, Ka, dra, k0a, LANE, SCR); \
            it = itn; if (!hn) break; \
            itn = it + (NGW_); hn = itn < (IT1); \
            if (hn) { CV_DECODE(itn, Wa, lda, ga, Ta, Ka, dra, k0a, n0a); CV_LOAD(va, Wa, lda, k0a, n0a, LANE); } \
            CV_PROC(vb, gb, Tb, Kb, drb, k0b, LANE, SCR); \
            it = itn; } } while (0)

template <int PH_LO, int PH_HI>
__global__ void __launch_bounds__(NWAVES * 64, 2) fwd_kernel(Args args) {
    extern __shared__ __attribute__((aligned(16))) unsigned char lds_raw[];
    LAS unsigned char* lds = (LAS unsigned char*)lds_raw;
    volatile LAS unsigned* MISC = (volatile LAS unsigned*)(lds + MISC_OFF);
    const int tid = threadIdx.x, lane = tid & 63, wave = __builtin_amdgcn_readfirstlane(tid >> 6);
    const int G = gridDim.x; const int bx = blockIdx.x; const int vcu = (G % 8 == 0) ? (bx % 8) * (G / 8) + bx / 8 : bx;
    unsigned char* ws = args.ws;
    gu32* ctl = (gu32*)(ws + WS_CTL);
    constexpr int lo = PH_LO, hi_ph = PH_HI;
    for (int u = tid; u < (LDS_BYTES - LDSCTL_OFF) / 4; u += NWAVES * 64) ((LAS unsigned*)(lds + LDSCTL_OFF))[u] = 0u;
    __syncthreads();
    XcdBarrier bar; bar.bar = (unsigned*)(ctl + CW_BAR); bar.x = 0; bar.st = nullptr;
    constexpr bool multi = (hi_ph - lo) > 1;
    if (multi) bar = xcd_barrier_post((unsigned*)(ctl + CW_BAR), MISC + 8);
#ifndef PH_MASK
#define PH_MASK 0xFFF
#endif
#define IN(k) ((((PH_MASK) >> (k)) & 1) && lo <= (k) && (k) < hi_ph)
#ifndef BAR_TWICE
#define BAR_TWICE 0
#endif
#ifndef PROBE_KIND
#define PROBE_KIND 0
#endif
#ifndef DUP_MASK
#define DUP_MASK 0
#endif
#define OPQV(x) ({ int v_ = (x); asm volatile("" : "+v"(v_)); v_; })
#define REP(k) for (int rep_ = 0; rep_ < 1 + (((DUP_MASK) >> (k)) & 1); ++rep_)
#define SEAM(k) do { if (IN(k) && IN((k) + 1)) { xcd_barrier_fn((GAS unsigned*)bar.bar, bar.x, bar.st); if (BAR_TWICE) xcd_barrier_fn((GAS unsigned*)bar.bar, bar.x, bar.st); } } while (0)
#define GSEAM(k, seam_) do { if (IN(k) && IN((k) + 1)) { if (DUP_MASK == 0 && BAR_TWICE == 0 && G == 256) group_barrier_fn((GAS unsigned*)(ctl + CW_GRP + ((bx & 63) * 8 + (seam_)) * 64), same_xcd, (GAS unsigned*)(ctl + CW_TMO)); else xcd_barrier_fn((GAS unsigned*)bar.bar, bar.x, bar.st); } } while (0)
#define WSO() ({ GAS unsigned char* p_ = (GAS unsigned char*)ws; asm volatile("" : "+s"(p_)); (unsigned char*)p_; })
#define OPQI(x) ({ int v_ = (x); asm volatile("" : "+s"(v_)); v_; })
#define W_INA ((bf16*)(WSO() + WS_WINA))
#define W_MKV ((bf16*)(WSO() + WS_WMKV))
#define W_OUT ((bf16*)(WSO() + WS_WOUT))
#define W_GU ((bf16*)(WSO() + WS_WGU))
#define W_DN ((bf16*)(WSO() + WS_WDN))
#define W_P1 ((bf16*)(WSO() + WS_WP1))
#define W_SP ((bf16*)(WSO() + WS_WSP))
#define MN ((bf16*)(WSO() + WS_MN))
#define KVM ((bf16*)(WSO() + WS_KVM))
#define VST ((float*)(WSO() + WS_VST))
#define FG ((float*)(WSO() + WS_FG))
#define BIASB ((float*)(WSO() + WS_BIAS))
#define XN ((bf16*)(WSO() + WS_XN))
#define MIX ((bf16*)(WSO() + WS_MIX))
#define HB ((bf16*)(WSO() + WS_H))
#define UB ((bf16*)(WSO() + WS_U))
#define GVB ((bf16*)(WSO() + WS_GV))
#define QM0 ((bf16*)(WSO() + WS_QM0))
#define QB ((bf16*)(WSO() + WS_Q))
#define KB ((bf16*)(WSO() + WS_K))
#define VB ((bf16*)(WSO() + WS_V))
#define QM1 ((bf16*)(WSO() + WS_QM1))
#define XSLOT ((unsigned*)(WSO() + WS_XS))
    unsigned* const tmo = (unsigned*)(ctl + CW_TMO);

REP(0) {     if (IN(0)) {
        LAS float* scr = (LAS float*)(lds + RING_OFF + wave * 16384);
        const int vcu0 = OPQI(vcu), G0 = OPQI(G); const int tid0 = OPQV(threadIdx.x), lane0 = tid0 & 63;
        const int gw = vcu0 * NWAVES + wave, NGW = G0 * NWAVES;
        bf16* const w_sp = W_SP; bf16* const xn = XN; bf16* const mn = MN; float* const ssq0 = (float*)XSLOT + (size_t)7 * 65536;
        const int hw = vcu0 * (NWAVES / 2) + (wave >> 1), NHW = G0 * (NWAVES / 2);
        if ((wave & 1) == 0) CONVERT_ITEMS(0, CV_STAGE_A, hw, NHW, lane0, scr);
        const int gt = vcu0 * NWAVES * 64 + tid0, NGT = G0 * NWAVES * 64;
        for (int i = gt; i < 7 * SEAM_BANK; i += NGT) ((unsigned*)ctl)[CW_SEAM + i] = 0u;
        for (int i = gt; i < 64 * 8 * 64; i += NGT) ((unsigned*)ctl)[CW_GRP + i] = 0u;
        for (int i = gt; i < 4 * 65536; i += NGT) XSLOT[(size_t)(2 * (i >> 16)) * 65536 + (i & 65535)] = pg8::XS_EMPTY;
        if (tid0 == 0) __hip_atomic_store(ctl + CW_XCC + bx, xb_xcc_id() + 1u, RLX_AGENT);
        for (int i = gt; i < NGRP * 128 * 128; i += NGT) { const int t = (i >> 7) & 127, s = i & 127; w_sp[i] = (s <= t) ? (bf16)f2bf(args.in[I_W_SP][i]) : (bf16)0; }
        {
            constexpr int NROWS = M + BATCH * NMEM;
#define ROW_LOAD(m_, v_) do { if ((m_) < NROWS) { const float* src_ = ((m_) < M) ? args.in[I_X] + (size_t)(m_) * D : args.in[I_MEM] + (size_t)((m_) - M) * D; const GAS f32x4* xr_ = (const GAS f32x4*)src_ + lane0; \
                _Pragma("unroll") for (int j_ = 0; j_ < 4; ++j_) v_[j_] = __builtin_nontemporal_load(xr_ + 64 * j_); } } while (0)
#define ROW_PROC(m_, v_) do { if ((m_) < NROWS) { bf16* dst_ = ((m_) < M) ? xn + (size_t)(m_) * D : mn + (size_t)((m_) - M) * D; float s2_ = 0.f; \
                _Pragma("unroll") for (int j_ = 0; j_ < 4; ++j_) s2_ += (v_[j_].x * v_[j_].x + v_[j_].y * v_[j_].y) + (v_[j_].z * v_[j_].z + v_[j_].w * v_[j_].w); \
                const float tot_ = wave_sum(s2_); float rstd_ = 1.f; \
                if ((m_) < M) { if (lane0 == 0) *(f32x4*)(ssq0 + (size_t)(m_) * 4) = (f32x4){tot_, 0.f, 0.f, 0.f}; }     \
                else rstd_ = 1.f / sqrtf(tot_ * (1.f / D) + RMS_EPS); \
                GAS unsigned long long* o8_ = (GAS unsigned long long*)dst_ + lane0; \
                _Pragma("unroll") for (int j_ = 0; j_ < 4; ++j_) o8_[64 * j_] = (unsigned long long)pk2(v_[j_].x * rstd_, v_[j_].y * rstd_) | ((unsigned long long)pk2(v_[j_].z * rstd_, v_[j_].w * rstd_) << 32); } } while (0)
            f32x4 a0[4], a1[4], b0[4], b1[4];
            if (wave & 1) {
            int m = hw; ROW_LOAD(m, a0); ROW_LOAD(m + NHW, a1);
            while (m < NROWS) {
                ROW_LOAD(m + 2 * NHW, b0); ROW_LOAD(m + 3 * NHW, b1);
                ROW_PROC(m, a0); ROW_PROC(m + NHW, a1);
                m += 2 * NHW; if (m >= NROWS) break;
                ROW_LOAD(m + 2 * NHW, a0); ROW_LOAD(m + 3 * NHW, a1);
                ROW_PROC(m, b0); ROW_PROC(m + NHW, b1);
                m += 2 * NHW;
            }
            }
#undef ROW_LOAD
#undef ROW_PROC
        }
    }
    SEAM(0); }

#define LAYER_BODY(LAYER_) do { constexpr int layer = (LAYER_); \
        const int pb = layer * 6; \
        if (layer == 0) { \
REP(1) {             if (IN(1)) { \
                pg8::SchedT<1> S; S.init(XN, W_INA, M, N_INA, D, OPQI(G), OPQI(bx)); S.extra(MN, W_MKV); \
                build_rtab(lds, S, (const float*)XSLOT + (size_t)7 * 65536); \
                pg8::EpiP1 E{UB, GVB, QM0, KVM, VST, (const LAS float*)(lds + RTAB_OFF)}; \
                pg8::gemm_phase<pg8::EpiP1, pg8::SchedT<1>, true, 16>(lds + RING_OFF, D, S, E); \
                if (rep_ == 0) { const int c1 = OPQI(bx), G1 = OPQI(G); \
                    if (c1 >= 192 && (c1 & 63) < 16) { if (threadIdx.x == 0) { __builtin_amdgcn_fence(__ATOMIC_RELEASE, "agent"); asm volatile("s_waitcnt vmcnt(0)" ::: "memory"); (void)xb_add((unsigned*)ctl + CW_KVM, 1u); } } \
                    if (G1 == 256 && c1 >= 192 && (c1 & 63) >= 16) { const int tid1 = OPQV(threadIdx.x), lane1 = tid1 & 63; LAS float* scr1 = (LAS float*)(lds + RING_OFF + wave * 16384); \
                        const int w1 = (c1 & 63) - 16; const int gw1 = w1 * NWAVES + wave, ngw1 = 48 * NWAVES; \
                        CONVERT_ITEMS(CV_P1W_LO, CV_NITEMS, gw1, ngw1, lane1, scr1); \
                        bf16* const w_p1 = W_P1; \
                        for (int i = w1 * NWAVES * 64 + tid1; i < 256 * D; i += 48 * NWAVES * 64) { const int r = i >> 10, k = i & 1023; \
                            w_p1[(size_t)(2560 + r) * D + k] = (r < FOXH) ? (bf16)f2bf(args.in[I_W_SKV][(size_t)k * N_SKV + 2 * MAINW + r] * args.in[I_LN_SHARED][k]) : (bf16)0; } } } \
            } \
            GSEAM(1, 5); } \
REP(2) {             if (IN(2)) { \
                const int c2 = OPQI(bx); const int pm2 = 8 * (c2 & 7) + ((c2 >> 3) & 7), j2 = c2 >> 6;        \
                spatial_chunk(lds + RING_OFF, 2 * pm2 + (j2 >> 1), (j2 & 1) * 3, UB, GVB, VST, W_SP, args.in[I_B_SP], args.in[I_LN_V_G], args.in[I_LN_V_B], MIX); \
                if (threadIdx.x == 0) { unsigned sp = 0u; while (xb_ld((unsigned*)ctl + CW_KVM) < 16u) { __builtin_amdgcn_s_sleep(1); if ((++sp & 255u) == 0u) { if (xb_ld((unsigned*)ctl + CW_TMO)) break; if (sp > XB_SPIN_CAP) { atomicAdd((unsigned*)ctl + CW_TMO, 1u); break; } } } } \
                __syncthreads(); \
                { const int b = pm2 >> 4, hm = j2, qb = pm2 & 15; const size_t q0 = (size_t)b * SEQ + qb * 256; \
                  const attn_body::bf16* Kp = (const attn_body::bf16*)KVM + (size_t)b * NMEM * 512 + hm * 64; \
                  attn_body::attn_unit<8, false, false, MEMW, 512, D>((const attn_body::bf16*)QM0 + q0 * MEMW + hm * 64, Kp, Kp + MEMW, (attn_body::bf16*)MIX + q0 * D + MAINW + hm * 64, nullptr, nullptr, 4, (char*)lds_raw + RING_OFF); } \
            } \
            SEAM(2); } \
        } else { \
REP(6) {             if (IN(6)) { \
                pg8::SchedT<2> S; S.init(XN, W_P1, M, N_P1, D, OPQI(G), OPQI(bx)); \
                build_rtab(lds, S, (const float*)XSLOT + (size_t)3 * 65536); \
                pg8::EpiP6 E{QB, QM1, KB, VB, BIASB, FG, args.in[I_B_FORGET], (const LAS float*)(lds + RTAB_OFF), (LAS float*)(lds + RTAB_OFF + RTAB_UNITS * 1024), (const unsigned*)ctl + CW_P5D, (IN(5) ? (unsigned)G : 0u)}; \
                pg8::gemm_phase<pg8::EpiP6, pg8::SchedT<2>, true, 16>(lds + RING_OFF, D, S, E); \
            } \
            SEAM(6); } \
REP(8) {             if (IN(8)) { \
                const int vcu8 = OPQI(vcu); \
                const int grp = vcu8 >> 4, j = vcu8 & 15; \
                for (int i = 0; i < 3; ++i) { \
                    const int e = FOX_TAB[j][i], bh = grp * 3 + (e >> 4), qb = e & 15, b = bh / FOXH, h = bh % FOXH; const size_t r0 = (size_t)b * SEQ, q0 = r0 + qb * 256; \
                    attn_body::attn_unit<64, true, true, MAINW, MAINW, D>((const attn_body::bf16*)QB + q0 * MAINW + h * 64, (const attn_body::bf16*)KB + r0 * MAINW + h * 64, (const attn_body::bf16*)VB + r0 * MAINW + h * 64, \
                                                                        (attn_body::bf16*)MIX + q0 * D + h * 64, BIASB + (size_t)bh * SEQ, FG + (size_t)b * 16 * FOXH + h, 4 * qb + 4, (char*)lds_raw + RING_OFF); \
                } \
                { const int b = vcu8 >> 6, hm = (vcu8 >> 4) & 3, qb = vcu8 & 15; const size_t q0 = (size_t)b * SEQ + qb * 256; \
                  const attn_body::bf16* Kp = (const attn_body::bf16*)KVM + (size_t)1024 * 512 + (size_t)b * NMEM * 512 + hm * 64; \
                  attn_body::attn_unit<8, false, false, MEMW, 512, D>((const attn_body::bf16*)QM1 + q0 * MEMW + hm * 64, Kp, Kp + MEMW, (attn_body::bf16*)MIX + q0 * D + MAINW + hm * 64, nullptr, nullptr, 4, (char*)lds_raw + RING_OFF); } \
            } \
            SEAM(8); } \
        } \
        const int p3 = layer == 0 ? 3 : 9; \
REP(p3) {         if (IN(p3)) { \
            const unsigned poison = (__hip_atomic_load(ctl + CW_TMO, RLX_AGENT) != 0u); \
            pg8::Sched S; S.init(MIX, W_OUT + (size_t)layer * D * D, M, D, D, OPQI(G), OPQI(bx)); \
            const int bk = layer * 4; \
            pg8::RowSumsq st1{XSLOT + (size_t)(bk + 0) * 65536, (unsigned*)ctl + CW_SEAM + (bk + 0) * SEAM_BANK, tmo, RMS_EPS, 0x700u + 0x40u * (unsigned)(bk + 0)}; \
            pg8::EpiRmsRes<false, false> E{nullptr, XN, nullptr, XN, (float*)XSLOT + (size_t)(bk + 1) * 65536, args.in[I_LN_MIX_POST] + layer * D, st1, poison, 0}; \
            pg8::gemm_phase<pg8::EpiRmsRes<false, false>, pg8::Sched, false>(lds + RING_OFF, D, S, E); \
        } \
        GSEAM(p3, layer * 2 + 0); } \
REP(p3 + 1) {         if (IN(p3 + 1)) { \
            typedef pg8::SchedT<(layer == 1 && DUP_MASK == 0) ? 3 : 0> SchedGU; \
            SchedGU S; S.init(XN, W_GU + (size_t)layer * 2 * FF * D, M, 2 * FF, D, OPQI(G), OPQI(bx)); \
            build_rtab(lds, S, (const float*)XSLOT + (size_t)(layer * 4 + 1) * 65536); \
            pg8::EpiGateUp E{HB, (const LAS float*)(lds + RTAB_OFF)}; \
            pg8::gemm_phase<pg8::EpiGateUp, SchedGU, true, 8>(lds + RING_OFF, D, S, E, (rep_ == 0 && (((DUP_MASK) >> (p3 + 1)) & 1)) ? PROBE_KIND : 0); \
            if (layer == 0 && rep_ == 0) { \
                const int c4 = OPQI(bx), G4 = OPQI(G); const int nbusy = (M / 256) * (2 * FF / 256) - 5 * G4; \
                if (G4 == 256 && c4 >= nbusy) { \
                    const int tid4 = OPQV(threadIdx.x), lane4 = tid4 & 63; LAS float* scr4 = (LAS float*)(lds + RING_OFF + wave * 16384); \
                    const int gw4 = (c4 - nbusy) * NWAVES + wave, ngw4 = (G4 - nbusy) * NWAVES; \
                    CONVERT_ITEMS(CV_STAGE_A, CV_P1W_LO, gw4, ngw4, lane4, scr4); \
                } \
            } \
        } \
        GSEAM(p3 + 1, layer * 2 + 1); } \
REP(p3 + 2) {         if (IN(p3 + 2)) { \
            unsigned poison = (__hip_atomic_load(ctl + CW_TMO, RLX_AGENT) != 0u); \
            if (multi) poison |= (__hip_atomic_load(ctl + CW_BAR + XB_TMO, RLX_AGENT) != 0u); \
            pg8::Sched S; S.init(HB, W_DN + (size_t)layer * D * FF, M, D, FF, OPQI(G), OPQI(bx)); \
            const int bk = layer * 4 + 2; \
            pg8::RowSumsq st1{XSLOT + (size_t)(bk + 0) * 65536, (unsigned*)ctl + CW_SEAM + (bk + 0) * SEAM_BANK, tmo, RMS_EPS, 0x700u + 0x40u * (unsigned)(bk + 0)}; \
            pg8::EpiRmsRes<false, layer == 1> E{nullptr, XN, layer == 0 ? nullptr : args.out, XN, (float*)XSLOT + (size_t)(bk + 1) * 65536, args.in[I_LN_FFN_POST] + layer * D, st1, poison, (rep_ == 0 && (((DUP_MASK) >> (p3 + 2)) & 1)) ? 1 : 0}; \
            pg8::gemm_phase<pg8::EpiRmsRes<false, layer == 1>, pg8::Sched, false>(lds + RING_OFF, FF, S, E); \
        } \
        if (layer == 0) { if (IN(p3 + 2) && rep_ == 0) { __syncthreads(); if (threadIdx.x == 0) (void)xb_add((unsigned*)ctl + CW_P5D, 1u); } GSEAM(p3 + 2, 4); } else { SEAM(p3 + 2); } } \
        (void)pb; \
    } while (0)
    int same_xcd = 0;
    if (multi && G == 256) {
        const unsigned x0 = __hip_atomic_load(ctl + CW_XCC + (bx & 63), RLX_AGENT), x1 = __hip_atomic_load(ctl + CW_XCC + (bx & 63) + 64, RLX_AGENT), x2 = __hip_atomic_load(ctl + CW_XCC + (bx & 63) + 128, RLX_AGENT), x3 = __hip_atomic_load(ctl + CW_XCC + (bx & 63) + 192, RLX_AGENT);
        same_xcd = __builtin_amdgcn_readfirstlane((x0 != 0u && x0 == x1 && x0 == x2 && x0 == x3) ? 1 : 0);
    }
    LAYER_BODY(0);
    LAYER_BODY(1);
#undef LAYER_BODY
#undef IN
#undef SEAM
}
#undef WSO

extern "C" void kernel_launch(void* const* d_in, const int* in_sizes, int n_in, void* d_out, int out_size, void* d_ws, size_t ws_size, hipStream_t stream) {
    static int grid = 0;
    if (grid == 0) {
        if (n_in != 21 || in_sizes[0] != M * D || out_size != M * D || ws_size < WS_END) { fprintf(stderr, "kernel_launch: unexpected problem (n_in %d, in0 %d, out %d, ws %zu); nothing launched\n", n_in, n_in > 0 ? in_sizes[0] : -1, out_size, ws_size); grid = -1; return; }
        int dev = 0, cus = 0, per_cu = 0;
        if (hipGetDevice(&dev) != hipSuccess || hipDeviceGetAttribute(&cus, hipDeviceAttributeMultiprocessorCount, dev) != hipSuccess) { fprintf(stderr, "kernel_launch: device query failed\n"); grid = -1; return; }
#if MK_N_LAUNCHES == 1
        if (hipFuncSetAttribute((const void*)fwd_kernel<0, NPHASE>, hipFuncAttributeMaxDynamicSharedMemorySize, LDS_BYTES) != hipSuccess) { fprintf(stderr, "kernel_launch: hipFuncSetAttribute failed\n"); grid = -1; return; }
        if (hipOccupancyMaxActiveBlocksPerMultiprocessor(&per_cu, (const void*)fwd_kernel<0, NPHASE>, NWAVES * 64, LDS_BYTES) != hipSuccess || per_cu < 1) { fprintf(stderr, "kernel_launch: occupancy query reports %d workgroups per CU\n", per_cu); per_cu = 1; }
#else
#define SETATTR_PH(p) (void)hipFuncSetAttribute((const void*)fwd_kernel<p, p + 1>, hipFuncAttributeMaxDynamicSharedMemorySize, LDS_BYTES)
        SETATTR_PH(0); SETATTR_PH(1); SETATTR_PH(2); SETATTR_PH(3); SETATTR_PH(4); SETATTR_PH(5); SETATTR_PH(6); SETATTR_PH(7); SETATTR_PH(8); SETATTR_PH(9); SETATTR_PH(10); SETATTR_PH(11);
        per_cu = 1;
#endif
        (void)hipGetLastError();
        grid = cus * 1;
        if (grid != 256) { fprintf(stderr, "kernel_launch: this kernel needs a 256-CU device (got %d CUs)\n", cus); grid = -1; return; }
    }
    if (grid < 0) return;
    if (hipMemsetAsync((char*)d_ws + WS_CTL, 0, CTL_ZERO_BYTES, stream) != hipSuccess) { fprintf(stderr, "kernel_launch: hipMemsetAsync failed\n"); return; }
    Args a{};
    for (int i = 0; i < 21; ++i) a.in[i] = (const float*)d_in[i];
    a.out = (float*)d_out; a.ws = (unsigned char*)d_ws;
#if MK_N_LAUNCHES == 1
#ifndef PLAIN_LAUNCH
#define PLAIN_LAUNCH 0
#endif
#if PLAIN_LAUNCH
    hipLaunchKernelGGL((fwd_kernel<0, NPHASE>), dim3(grid), dim3(NWAVES * 64), LDS_BYTES, stream, a);
#else
    void* kargs[] = {&a};
    hipError_t e = hipLaunchCooperativeKernel((const void*)fwd_kernel<0, NPHASE>, dim3(grid), dim3(NWAVES * 64), kargs, LDS_BYTES, stream);
    if (e != hipSuccess) fprintf(stderr, "kernel_launch: cooperative launch failed: %s\n", hipGetErrorString(e));
#endif
#else
#define LAUNCH_PH(p) hipLaunchKernelGGL((fwd_kernel<p, p + 1>), dim3(grid), dim3(NWAVES * 64), LDS_BYTES, stream, a)
    LAUNCH_PH(0); LAUNCH_PH(1); LAUNCH_PH(2); LAUNCH_PH(3); LAUNCH_PH(4); LAUNCH_PH(5); LAUNCH_PH(6); LAUNCH_PH(7); LAUNCH_PH(8); LAUNCH_PH(9); LAUNCH_PH(10); LAUNCH_PH(11);
#endif
}
```
